# Optimizing an MI355X kernel written in HIP

```python
import jax, jax.numpy as jnp
from jax import lax
import numpy as np

D_MODEL = 2048
BATCH = 4
SEQ = 4096
DEPTH = 2

N_META = 16
CHUNK = 128
PAD = CHUNK - N_META
RMS_EPS = 1e-6
GN_EPS = 1e-6
NEG_INF = -1e30
RET_HEADS = 8
RET_DK = D_MODEL // RET_HEADS
RET_DV = 2 * D_MODEL // RET_HEADS
RET_QK = RET_HEADS * RET_DK
RET_V = RET_HEADS * RET_DV
ROPE_BASE = 10000.0
FOX_HEADS = 16
FOX_DH = D_MODEL // FOX_HEADS
N_GROUPS = 4
EXPERTS_PER_GROUP = 8
EXPERT_FF = D_MODEL // 4
TOP_K_INNER = 2
N_RET = (DEPTH + 1) // 2
N_FOX = DEPTH // 2

kernel_name = 'hybrid_retention_fox_hmoe_meta'


def rms_norm(h, g):
    hf = h.astype(jnp.float32)
    y = hf * lax.rsqrt(jnp.mean(hf * hf, axis=-1, keepdims=True) + RMS_EPS)
    return (y * g.astype(jnp.float32)).astype(h.dtype)


def rotary(u, pos):
    half = u.shape[-1] // 2
    inv = ROPE_BASE ** (-jnp.arange(half, dtype=jnp.float32) / half)
    ang = pos.astype(jnp.float32)[:, None] * inv[None, :]
    cos = jnp.cos(ang)[None, :, None, :]
    sin = jnp.sin(ang)[None, :, None, :]
    u1, u2 = u[..., :half], u[..., half:]
    return jnp.concatenate([u1 * cos - u2 * sin, u1 * sin + u2 * cos], axis=-1)


def retention(h, w_in, gn_gain, w_out):
    bsz, seq_len, _ = h.shape
    lp = seq_len + PAD
    nc = lp // CHUNK
    hp = jnp.pad(h, ((0, 0), (PAD, 0), (0, 0)))
    proj = hp @ w_in
    q, k, v, g = jnp.split(proj, [RET_QK, 2 * RET_QK, 2 * RET_QK + RET_V], axis=-1)
    pos = jnp.arange(lp) - PAD
    valid = (jnp.arange(lp) >= PAD)[None, :, None, None]
    q = rotary(q.reshape(bsz, lp, RET_HEADS, RET_DK).astype(jnp.float32), pos)
    k = rotary(k.reshape(bsz, lp, RET_HEADS, RET_DK).astype(jnp.float32), pos) * (RET_DK ** -0.5)
    k = jnp.where(valid, k, 0.0)
    v = jnp.where(valid, v.reshape(bsz, lp, RET_HEADS, RET_DV).astype(jnp.float32), 0.0)
    log_g = jnp.log1p(-jnp.exp2(-5.0 - jnp.arange(RET_HEADS, dtype=jnp.float32)))
    idx = jnp.arange(CHUNK, dtype=jnp.float32)
    diff = idx[:, None] - idx[None, :]
    dmat = jnp.where(diff[None] >= 0, jnp.exp(jnp.maximum(diff, 0.0)[None] * log_g[:, None, None]), 0.0)
    xi = jnp.exp((idx + 1.0)[None, :] * log_g[:, None])
    zeta = jnp.exp((CHUNK - 1.0 - idx)[None, :] * log_g[:, None])
    g_chunk = jnp.exp(CHUNK * log_g)

    def to_chunks(u):
        return u.reshape(bsz, nc, CHUNK, RET_HEADS, u.shape[-1]).transpose(1, 0, 3, 2, 4)

    def step(state, inp):
        qc, kc, vc = inp
        scores = jnp.einsum('bhid,bhjd->bhij', qc, kc) * dmat[None]
        inner = jnp.einsum('bhij,bhje->bhie', scores, vc)
        cross = jnp.einsum('bhid,bhde->bhie', qc, state) * xi[None, :, :, None]
        new_state = g_chunk[None, :, None, None] * state + jnp.einsum(
            'bhjd,bhje->bhde', kc, vc * zeta[None, :, :, None])
        return new_state, inner + cross

    s0 = jnp.zeros((bsz, RET_HEADS, RET_DK, RET_DV), jnp.float32)
    _, ys = lax.scan(step, s0, (to_chunks(q), to_chunks(k), to_chunks(v)))
    y = ys.transpose(1, 0, 3, 2, 4).reshape(bsz, lp, RET_HEADS, RET_DV)
    mu = jnp.mean(y, axis=-1, keepdims=True)
    var = jnp.mean(jnp.square(y - mu), axis=-1, keepdims=True)
    yn = (y - mu) * lax.rsqrt(var + GN_EPS) * gn_gain.astype(jnp.float32)[None, None]
    gated = jax.nn.silu(g.astype(jnp.float32)) * yn.reshape(bsz, lp, RET_V)
    out = gated.astype(h.dtype) @ w_out
    return out[:, PAD:]


def forgetting_attention(h, w_in, b_f, w_out):
    bsz, seq_len, dm = h.shape
    lp = seq_len + PAD
    nb = lp // CHUNK
    hp = jnp.pad(h, ((0, 0), (PAD, 0), (0, 0)))
    proj = hp @ w_in
    q, k, v, f_logit = jnp.split(proj, [dm, 2 * dm, 3 * dm], axis=-1)
    key_pos = jnp.arange(lp)
    key_valid = key_pos >= PAD
    log_f = jax.nn.log_sigmoid(f_logit.astype(jnp.float32) + b_f.astype(jnp.float32))
    log_f = jnp.where(key_valid[None, :, None], log_f, 0.0)
    c = jnp.cumsum(log_f, axis=1)
    c_keys = c.transpose(0, 2, 1)
    k_all = k.reshape(bsz, lp, FOX_HEADS, FOX_DH).transpose(0, 2, 1, 3)
    v_all = v.reshape(bsz, lp, FOX_HEADS, FOX_DH).transpose(0, 2, 1, 3)
    q_blk = q.reshape(bsz, nb, CHUNK, FOX_HEADS, FOX_DH).transpose(1, 0, 3, 2, 4)
    c_blk = c.reshape(bsz, nb, CHUNK, FOX_HEADS).transpose(1, 0, 3, 2)
    pos_blk = key_pos.reshape(nb, CHUNK)
    scale = FOX_DH ** -0.5

    def block(args):
        qb, cqb, qpos = args
        s = jnp.einsum('bhqd,bhkd->bhqk', qb, k_all, preferred_element_type=jnp.float32) * scale
        s = s + cqb[..., None] - c_keys[:, :, None, :]
        mask = (key_pos[None, :] <= qpos[:, None]) & key_valid[None, :]
        s = jnp.where(mask[None, None], s, NEG_INF)
        p = jax.nn.softmax(s, axis=-1)
        return jnp.einsum('bhqk,bhkd->bhqd', p.astype(v_all.dtype), v_all)

    o = lax.map(block, (q_blk, c_blk, pos_blk))
    o = o.transpose(1, 0, 3, 2, 4).reshape(bsz, lp, dm)
    return (o @ w_out)[:, PAD:]


def hierarchical_moe(h, w_rg, b_rg, w_re, b_re, w_gate, w_up, w_down):
    bsz, seq_len, dm = h.shape
    t = h.reshape(-1, dm)
    lg = (t @ w_rg).astype(jnp.float32) + b_rg.astype(jnp.float32)
    pg = jax.nn.softmax(lg, axis=-1)
    g_sel = jnp.argmax(lg, axis=-1)
    p_gsel = jnp.take_along_axis(pg, g_sel[:, None], axis=1)[:, 0]
    le = jnp.einsum('td,dge->tge', t, w_re).astype(jnp.float32) + b_re.astype(jnp.float32)[None]
    le_sel = jnp.take_along_axis(le, g_sel[:, None, None], axis=1)[:, 0]
    pe = jax.nn.softmax(le_sel, axis=-1)
    top_w, top_i = lax.top_k(pe, TOP_K_INNER)
    top_w = top_w / jnp.sum(top_w, axis=-1, keepdims=True)
    ew = jnp.sum(jax.nn.one_hot(top_i, EXPERTS_PER_GROUP, dtype=jnp.float32) * top_w[..., None], axis=1)
    combine = (jax.nn.one_hot(g_sel, N_GROUPS, dtype=jnp.float32) * p_gsel[:, None])[:, :, None] * ew[:, None, :]
    combine = combine.astype(h.dtype)
    out = jnp.zeros_like(t)
    for g in range(N_GROUPS):
        a = jnp.einsum('td,edf->tef', t, w_gate[g])
        u = jnp.einsum('td,edf->tef', t, w_up[g])
        hid = jax.nn.silu(a) * u * combine[:, g, :, None]
        out = out + jnp.einsum('tef,efd->td', hid, w_down[g])
    return out.reshape(bsz, seq_len, dm)


def setup_inputs(seed: int = 0) -> dict:
    key = jax.random.key(seed)
    ks = jax.random.split(key, 20)
    f32 = jnp.float32

    def nrm(k, shape, fan_in):
        return jax.random.normal(k, shape, f32) * (fan_in ** -0.5)

    def gain(k, shape):
        return 1.0 + 0.02 * jax.random.normal(k, shape, f32)

    G, E, F, D = N_GROUPS, EXPERTS_PER_GROUP, EXPERT_FF, D_MODEL
    return {
        'x': jax.random.normal(ks[0], (BATCH, SEQ, D), f32),
        'meta_tokens': jax.random.normal(ks[1], (N_META, D), f32),
        'norm_mixer': gain(ks[2], (DEPTH, D)),
        'norm_ffn': gain(ks[3], (DEPTH, D)),
        'norm_final': gain(ks[4], (D,)),
        'ret_w_in': nrm(ks[5], (N_RET, D, 2 * RET_QK + 2 * RET_V), D),
        'ret_gn': gain(ks[6], (N_RET, RET_HEADS, RET_DV)),
        'ret_w_out': nrm(ks[7], (N_RET, RET_V, D), RET_V),
        'fox_w_in': nrm(ks[8], (N_FOX, D, 3 * D + FOX_HEADS), D),
        'fox_b_f': jax.random.uniform(ks[9], (N_FOX, FOX_HEADS), f32, 1.0, 6.0),
        'fox_w_out': nrm(ks[10], (N_FOX, D, D), D),
        'moe_w_rg': nrm(ks[11], (DEPTH, D, G), D),
        'moe_b_rg': 0.01 * jax.random.normal(ks[12], (DEPTH, G), f32),
        'moe_w_re': nrm(ks[13], (DEPTH, D, G, E), D),
        'moe_b_re': 0.01 * jax.random.normal(ks[14], (DEPTH, G, E), f32),
        'moe_w_gate': nrm(ks[15], (DEPTH, G, E, D, F), D),
        'moe_w_up': nrm(ks[16], (DEPTH, G, E, D, F), D),
        'moe_w_down': nrm(ks[17], (DEPTH, G, E, F, D), F),
    }


def reference(x, meta_tokens, norm_mixer, norm_ffn, norm_final, ret_w_in, ret_gn, ret_w_out,
              fox_w_in, fox_b_f, fox_w_out, moe_w_rg, moe_b_rg, moe_w_re, moe_b_re,
              moe_w_gate, moe_w_up, moe_w_down):
    bsz = x.shape[0]
    meta = jnp.broadcast_to(meta_tokens.astype(x.dtype)[None], (bsz, N_META, x.shape[-1]))
    h = jnp.concatenate([meta, x], axis=1)
    for i in range(DEPTH):
        hn = rms_norm(h, norm_mixer[i])
        j = i // 2
        if i % 2 == 0:
            h = h + retention(hn, ret_w_in[j], ret_gn[j], ret_w_out[j])
        else:
            h = h + forgetting_attention(hn, fox_w_in[j], fox_b_f[j], fox_w_out[j])
        hn = rms_norm(h, norm_ffn[i])
        h = h + hierarchical_moe(hn, moe_w_rg[i], moe_b_rg[i], moe_w_re[i], moe_b_re[i],
                                 moe_w_gate[i], moe_w_up[i], moe_w_down[i])
    return rms_norm(h, norm_final)[:, N_META:]
```

```cpp
#include <hip/hip_runtime.h>
#include <cstdio>
#include <cstdint>
__device__ __forceinline__ int mk_lane_id() { int l; asm volatile("v_mbcnt_lo_u32_b32 %0, -1, 0\n\tv_mbcnt_hi_u32_b32 %0, -1, %0" : "=v"(l)); return l; }
namespace pg8 {
#define PG8_LAS __attribute__((address_space(3)))
typedef unsigned short bf16_t;
typedef short bf16x8 __attribute__((ext_vector_type(8)));
typedef float f32x4 __attribute__((ext_vector_type(4)));
typedef unsigned u32x4 __attribute__((ext_vector_type(4)));
constexpr int BM = 256, BK = 64, HALF = 128, HTB = HALF * BK * 2  , STAGE_BYTES = 8 * HTB, NXCD = 8, WGM = 8;

__host__ __device__ __forceinline__ int lds_byte(int r, int c) { const int st = (r >> 4) * 2 + (c >> 5), rr = r & 15, cc = c & 31, ob = rr * 64 + cc * 2; return st * 1024 + (ob ^ (((ob >> 9) & 1) << 5)); }
__host__ __device__ __forceinline__ void stage_rc(int b, int& R, int& C) { const int st = b / 1024, sb = b % 1024, swz = sb ^ (((sb >> 9) & 1) << 5); R = (st >> 1) * 16 + swz / 64; C = (st & 1) * 32 + (swz % 64) / 2; }
__host__ __device__ __forceinline__ int perm32(int rho) { const int n = rho >> 4, i = rho & 15; return 8 * (i >> 2) + 4 * n + (i & 3); }

struct Unit { int pm, pn, ko; };
struct Gemm { const bf16_t* A; const bf16_t* Bt; int M, N, K, ld; };

struct StaticOrder {
    int nM, nN, nwg, G, c;
    __host__ __device__ void init(int M, int N, int G_, int c_) { nM = M / BM; nN = N / BM; nwg = nM * nN; G = G_; c = c_; }
    __host__ __device__ bool next(int i, Unit& u) const {
        const long L = (long)i * G + c; if (L >= nwg) return false;
        int wgid = (int)L; { const int q = nwg / NXCD, r = nwg % NXCD, xcd = wgid % NXCD, off = wgid / NXCD; wgid = (xcd < r ? xcd * (q + 1) : r * (q + 1) + (xcd - r) * q) + off; }
        const int nig = WGM * nN, gid = wgid / nig, fm = gid * WGM, gsz = (nM - fm) < WGM ? (nM - fm) : WGM;
        u.pm = fm + ((wgid % nig) % gsz); u.pn = (wgid % nig) / gsz; u.ko = 0; return true;
    }
    __device__ __forceinline__ void a_ready(const Unit&) const {}
    __device__ __forceinline__ void done(const Unit&) const {}
};
__device__ __forceinline__ unsigned cvt_pk_bf16(float lo, float hi) { unsigned r; asm volatile("v_cvt_pk_bf16_f32 %0, %1, %2" : "=v"(r) : "v"(lo), "v"(hi)); return r; }
template <int ACT  > struct EpiBf16 {
    static constexpr bool PERM = true, AFTER_DRAIN = false; static_assert(ACT == 0 || ACT == 1, "EpiBf16: ACT is 0 (none) or 1 (gelu_pk)");
    bf16_t* O; int ldc; const float* bias; int split_cols; size_t split_stride; float scale0;
    __device__ __forceinline__ void operator()(const f32x4 (&acc)[2][2][4][2], const Unit& u, int wr, int wc, int fr, int fq) const {
        const int row0 = u.pm * BM + wr * 64 + fr; int colt = u.pn * BM; bf16_t* base = O;
        float sc = 1.f; if (split_cols) { const int t = colt / split_cols; base += (size_t)t * split_stride; colt -= t * split_cols; if (t == 0) sc = scale0; }
        const int col0 = colt + wc * 32 + 8 * fq, bcol0 = u.pn * BM + wc * 32 + 8 * fq;
        f32x4 bv[2][2];
#pragma unroll
        for (int bj = 0; bj < 2; ++bj)
#pragma unroll
            for (int n = 0; n < 2; ++n) bv[bj][n] = bias ? *(const f32x4*)(bias + bcol0 + bj * HALF + 4 * n) : (f32x4){0.f, 0.f, 0.f, 0.f};
#pragma unroll
        for (int ai = 0; ai < 2; ++ai)
#pragma unroll
            for (int m = 0; m < 4; ++m) { bf16_t* rowp = base + (size_t)(row0 + ai * HALF + m * 16) * ldc + col0;
#pragma unroll
                for (int bj = 0; bj < 2; ++bj) { f32x4 v0 = acc[ai][bj][m][0] + bv[bj][0], v1 = acc[ai][bj][m][1] + bv[bj][1];
                    v0 = v0 * sc; v1 = v1 * sc; u32x4 w; w.x = cvt_pk_bf16(v0[0], v0[1]); w.y = cvt_pk_bf16(v0[2], v0[3]); w.z = cvt_pk_bf16(v1[0], v1[1]); w.w = cvt_pk_bf16(v1[2], v1[3]);
                    *(u32x4*)(rowp + bj * HALF) = w; } }
    }
};
template <class Epi, class Sched, bool ALIGN_EPI = false, bool SP2 = false, bool GATHER = false>
__device__ __forceinline__ void gemm_phase(PG8_LAS unsigned char* lds, const Gemm g, const Sched& S, const Epi& E, int wave_sgpr) {
    int tid_ = wave_sgpr * 64 + mk_lane_id(); asm volatile("" : "+v"(tid_));
    const int tid = tid_, wid = __builtin_amdgcn_readfirstlane(tid >> 6), lane = tid & 63, wr = wid >> 2, wc = wid & 3, fr = lane & 15, fq = lane >> 4;
    const int K = g.ld ? g.ld : g.K, nt = g.K / BK;
    unsigned voffA[2], voffB[2];
#pragma unroll
    for (int i = 0; i < 2; ++i) { int R, C; stage_rc(tid * 16 + i * 8192, R, C); const int Rb = Epi::PERM ? ((R & ~31) + perm32(R & 31)) : R;
        voffA[i] = (unsigned)(R * K + C) * 2u; voffB[i] = (unsigned)(Rb * K + C) * 2u; }
    static_assert(!GATHER || SP2, "the gather staging is written for the SP2 loop");
    const size_t kstep = (size_t)(BK * 2);
    const size_t hstep = (size_t)HALF * K * 2;
    const size_t tstep = 2 * hstep;
    const unsigned ldsw = (unsigned)wid * 1024u;
    const int aoff = lds_byte(wr * 64 + fr, fq * 8), boff = lds_byte(wc * 32 + fr, fq * 8);
#define PG8_SA(b, h) (((b) * 2 + (h)) * HTB)
#define PG8_SB(b, h) ((4 + (b) * 2 + (h)) * HTB)
#define PG8_STAGE(bufoff, gbase, voff) do { _Pragma("unroll") for (int _i = 0; _i < 2; ++_i) \
        __builtin_amdgcn_global_load_lds((const unsigned*)((const char*)(gbase) + (voff)[_i]), (PG8_LAS unsigned*)(lds + (bufoff) + ldsw + _i * 8192), 16, 0, 0); } while (0)
#define PG8_GFILL(u_, v_) do { _Pragma("unroll") for (int h_ = 0; h_ < 2; ++h_) _Pragma("unroll") for (int i_ = 0; i_ < 2; ++i_) { int R_, C_; stage_rc(tid * 16 + i_ * 8192, R_, C_); \
        v_[h_][i_] = ((unsigned)S.arow(u_, h_ * HALF + R_) * (unsigned)K + (unsigned)C_) * 2u; } } while (0)
#define PG8_STAGE_A(bufoff, gbase, half, nx) do { if constexpr (GATHER) { const unsigned s_[2] = {(nx) ? nvA[half][0] : cvA[half][0], (nx) ? nvA[half][1] : cvA[half][1]}; PG8_STAGE(bufoff, gbase, s_); } \
        else { PG8_STAGE(bufoff, (gbase) + (half) * hstep, voffA); } } while (0)
#define PG8_LDA(dst, b, h) do { _Pragma("unroll") for (int m = 0; m < 4; ++m) _Pragma("unroll") for (int k = 0; k < 2; ++k) dst[m][k] = *(const PG8_LAS bf16x8*)(lds + PG8_SA(b, h) + aoff + m * 2048 + k * 1024); } while (0)
#define PG8_LDB(dst, b, h) do { _Pragma("unroll") for (int n = 0; n < 2; ++n) _Pragma("unroll") for (int k = 0; k < 2; ++k) dst[n][k] = *(const PG8_LAS bf16x8*)(lds + PG8_SB(b, h) + boff + n * 2048 + k * 1024); } while (0)
#define PG8_MMA(ai, bj, At, Bt) do { __builtin_amdgcn_s_setprio(1); _Pragma("unroll") for (int m = 0; m < 4; ++m) _Pragma("unroll") for (int n = 0; n < 2; ++n) _Pragma("unroll") for (int k = 0; k < 2; ++k) \
        acc[ai][bj][m][n] = __builtin_amdgcn_mfma_f32_16x16x32_bf16(Bt[n][k], At[m][k], acc[ai][bj][m][n], 0, 0, 0); __builtin_amdgcn_s_setprio(0); } while (0)
#define PG8_WAIT_V(n) asm volatile("s_waitcnt vmcnt(" #n ")" ::: "memory")
#define PG8_WAIT_L(n) asm volatile("s_waitcnt lgkmcnt(" #n ")" ::: "memory")
#define PG8_BAR __builtin_amdgcn_s_barrier()
#define PG8_SCHED __builtin_amdgcn_sched_barrier(0)
    Unit cur, nxt; int ui = 0;
    if (!S.next(0, cur)) return;
    f32x4 acc[2][2][4][2];
#pragma unroll
    for (int a = 0; a < 2; ++a)
#pragma unroll
        for (int b = 0; b < 2; ++b)
#pragma unroll
            for (int m = 0; m < 4; ++m)
#pragma unroll
                for (int n = 0; n < 2; ++n) acc[a][b][m][n] = (f32x4){0.f, 0.f, 0.f, 0.f};
    bf16x8 At[4][2], B0[2][2], B1[2][2];
    unsigned cvA[2][2], nvA[2][2];
    if constexpr (GATHER) { PG8_GFILL(cur, cvA); PG8_GFILL(cur, nvA); }
    const char* cA = GATHER ? (const char*)g.A : (const char*)g.A + (size_t)cur.pm * tstep + (size_t)cur.ko * 2; const char* cB = (const char*)g.Bt + (size_t)cur.pn * tstep + (size_t)cur.ko * 2;
    S.a_ready(cur);
    if constexpr (SP2) {
        PG8_STAGE(PG8_SB(0, 0), cB, voffB); PG8_STAGE(PG8_SB(0, 1), cB + hstep, voffB); PG8_STAGE_A(PG8_SA(0, 0), cA, 0, false); PG8_STAGE_A(PG8_SA(0, 1), cA, 1, false);
        if (wr == 1) PG8_BAR;
        PG8_WAIT_V(2); PG8_BAR;
        PG8_STAGE(PG8_SB(1, 0), cB + kstep, voffB); PG8_STAGE_A(PG8_SA(1, 0), cA + kstep, 0, false); PG8_STAGE(PG8_SB(1, 1), cB + hstep + kstep, voffB);
        PG8_WAIT_V(6); PG8_BAR;
    } else {
        PG8_STAGE(PG8_SB(0, 0), cB, voffB); PG8_STAGE(PG8_SA(0, 0), cA, voffA); PG8_STAGE(PG8_SB(0, 1), cB + hstep, voffB); PG8_STAGE(PG8_SA(0, 1), cA + hstep, voffA);
        if (wr == 1) PG8_BAR;
        PG8_WAIT_V(4); PG8_BAR;
        PG8_STAGE(PG8_SB(1, 0), cB + kstep, voffB); PG8_STAGE(PG8_SA(1, 0), cA + kstep, voffA); PG8_STAGE(PG8_SB(1, 1), cB + hstep + kstep, voffB);
        PG8_WAIT_V(6); PG8_BAR;
    }
    for (;;) {
        const bool has_next = S.next(ui + 1, nxt);
        if constexpr (GATHER) { if (has_next) PG8_GFILL(nxt, nvA); }
        const char* nA = GATHER ? cA : has_next ? (const char*)g.A + (size_t)nxt.pm * tstep + (size_t)nxt.ko * 2 : cA; const char* nB = has_next ? (const char*)g.Bt + (size_t)nxt.pn * tstep + (size_t)nxt.ko * 2 : cB;
        for (int t = 0; t < nt; t += 2) {
            const bool last = (t == nt - 2);
            const char* a1 = cA + (size_t)(t + 1) * kstep;
            const char* a2 = last ? nA : cA + (size_t)(t + 2) * kstep; const char* b2 = last ? nB : cB + (size_t)(t + 2) * kstep;
            const char* a3 = a2 + kstep; const char* b3 = b2 + kstep;
            if (last && has_next) S.a_ready(nxt);
            if constexpr (SP2) {
            PG8_LDB(B0, 0, 0); PG8_LDB(B1, 0, 1); PG8_SCHED; PG8_LDA(At, 0, 0); PG8_STAGE_A(PG8_SA(1, 1), a1, 1, false);
            PG8_WAIT_V(8); PG8_WAIT_L(0); PG8_BAR; PG8_MMA(0, 0, At, B0); PG8_MMA(0, 1, At, B1); PG8_BAR; PG8_SCHED;
            PG8_LDA(At, 0, 1); PG8_STAGE(PG8_SB(0, 0), b2, voffB); PG8_STAGE(PG8_SB(0, 1), b2 + hstep, voffB); PG8_STAGE_A(PG8_SA(0, 0), a2, 0, last);
            PG8_WAIT_V(8); PG8_WAIT_L(0); PG8_BAR; PG8_MMA(1, 0, At, B0); PG8_MMA(1, 1, At, B1); PG8_BAR; PG8_SCHED;
            PG8_LDB(B0, 1, 0); PG8_LDB(B1, 1, 1); PG8_SCHED; PG8_LDA(At, 1, 0); PG8_STAGE_A(PG8_SA(0, 1), a2, 1, last);
            PG8_WAIT_V(8); PG8_WAIT_L(0); PG8_BAR; PG8_MMA(0, 0, At, B0); PG8_MMA(0, 1, At, B1); PG8_BAR; PG8_SCHED;
            PG8_LDA(At, 1, 1); PG8_STAGE(PG8_SB(1, 0), b3, voffB); PG8_STAGE(PG8_SB(1, 1), b3 + hstep, voffB); PG8_STAGE_A(PG8_SA(1, 0), a3, 0, last);
            PG8_WAIT_V(8); PG8_WAIT_L(0); PG8_BAR; PG8_MMA(1, 0, At, B0); PG8_MMA(1, 1, At, B1); PG8_BAR; PG8_SCHED;
            } else {
            PG8_LDB(B0, 0, 0); PG8_SCHED; PG8_LDA(At, 0, 0); PG8_STAGE(PG8_SA(1, 1), a1 + hstep, voffA);
            PG8_WAIT_L(8); PG8_BAR; PG8_WAIT_L(0); PG8_MMA(0, 0, At, B0); PG8_BAR; PG8_SCHED;
            PG8_LDB(B1, 0, 1); PG8_STAGE(PG8_SB(0, 0), b2, voffB);
            PG8_BAR; PG8_WAIT_L(0); PG8_MMA(0, 1, At, B1); PG8_BAR;
            PG8_LDA(At, 0, 1); PG8_STAGE(PG8_SA(0, 0), a2, voffA);
            PG8_BAR; PG8_WAIT_L(0); PG8_MMA(1, 0, At, B0); PG8_BAR; PG8_SCHED;
            PG8_STAGE(PG8_SB(0, 1), b2 + hstep, voffB);
            PG8_WAIT_V(6); PG8_BAR; PG8_MMA(1, 1, At, B1); PG8_BAR;
            PG8_LDB(B0, 1, 0); PG8_SCHED; PG8_LDA(At, 1, 0); PG8_STAGE(PG8_SA(0, 1), a2 + hstep, voffA);
            PG8_WAIT_L(8); PG8_BAR; PG8_WAIT_L(0); PG8_MMA(0, 0, At, B0); PG8_BAR; PG8_SCHED;
            PG8_LDB(B1, 1, 1); PG8_STAGE(PG8_SB(1, 0), b3, voffB);
            PG8_BAR; PG8_WAIT_L(0); PG8_MMA(0, 1, At, B1); PG8_BAR;
            PG8_LDA(At, 1, 1); PG8_STAGE(PG8_SA(1, 0), a3, voffA);
            PG8_BAR; PG8_WAIT_L(0); PG8_MMA(1, 0, At, B0); PG8_BAR; PG8_SCHED;
            PG8_STAGE(PG8_SB(1, 1), b3 + hstep, voffB);
            PG8_WAIT_V(6); PG8_BAR; PG8_MMA(1, 1, At, B1); PG8_BAR;
            }
        }
        if constexpr (ALIGN_EPI) { if (wr == 0) PG8_BAR; }
        if constexpr (!Epi::AFTER_DRAIN) { E(acc, cur, wr, wc, fr, fq); S.done(cur); }
        if (!has_next) break;
#pragma unroll
        for (int a = 0; a < 2; ++a)
#pragma unroll
            for (int b = 0; b < 2; ++b)
#pragma unroll
                for (int m = 0; m < 4; ++m)
#pragma unroll
                    for (int n = 0; n < 2; ++n) acc[a][b][m][n] = (f32x4){0.f, 0.f, 0.f, 0.f};
        cur = nxt; cA = nA; cB = nB; ++ui;
        if constexpr (GATHER) { _Pragma("unroll") for (int h_ = 0; h_ < 2; ++h_) _Pragma("unroll") for (int i_ = 0; i_ < 2; ++i_) cvA[h_][i_] = nvA[h_][i_]; }
        if constexpr (ALIGN_EPI) { if (wr == 1) PG8_BAR; }
    }
    PG8_WAIT_V(0);
    if constexpr (!ALIGN_EPI) { if (wr == 0) PG8_BAR; }
    PG8_BAR;
    if constexpr (Epi::AFTER_DRAIN) { E.fused(acc, cur, wr, wc, fr, fq, lds, wid, lane); S.done(cur); }
#undef PG8_SA
#undef PG8_SB
#undef PG8_STAGE
#undef PG8_STAGE_A
#undef PG8_GFILL
#undef PG8_LDA
#undef PG8_LDB
#undef PG8_MMA
#undef PG8_WAIT_V
#undef PG8_WAIT_L
#undef PG8_BAR
#undef PG8_SCHED
}
}
namespace fa {
constexpr int D = 128, RS = 2048, KMIN = 112;
constexpr float THR = 8.f; constexpr bool WSKIP = false;
constexpr float SCALE = 0.08838834764831845f;
constexpr int NW = 8, QBLK = 32, KVBLK = 64, QB = NW * QBLK;
constexpr int SHM_V = KVBLK * D * 2, SHM_K = KVBLK * D * 2;
constexpr int LDS_CK = 2 * SHM_V + 2 * SHM_K + NW * 64 * 4, LDS_BYTES = LDS_CK + 2 * 64 * 4;

typedef unsigned short bf16;
typedef short bf16x8 __attribute__((ext_vector_type(8)));
typedef short s16x4 __attribute__((ext_vector_type(4)));
typedef float f32x16 __attribute__((ext_vector_type(16)));
typedef float f32x4 __attribute__((ext_vector_type(4)));
typedef unsigned u32x4 __attribute__((ext_vector_type(4)));
template <class A, class Bt> struct same_t { static constexpr bool v = false; };
template <class A> struct same_t<A, A> { static constexpr bool v = true; };

#define KSWZ(row, colB) ((row) * 256 + ((colB) ^ (((row) & 7) << 4)))
#define SBAR() __builtin_amdgcn_sched_barrier(0)
__device__ __forceinline__ int v_st(int k, int c) { const int kk = (k & ~0xC) | ((k & 4) << 1) | ((k & 8) >> 1); return ((kk >> 3) * 4 + (c >> 5)) * 512 + ((kk & 7) * 32 + (c & 31)) * 2; }
__device__ __forceinline__ int v_rd_base(int lane) { return ((lane & 3) << 3) | (((lane >> 2) & 3) << 6) | (((lane >> 4) & 1) << 5) | (((lane >> 5) & 1) << 8); }
constexpr int v_rd_off(int d0, int ks, int half) { return d0 * 512 + ks * 4096 + half * 2048; }
__device__ __forceinline__ int crow(int r, int hi) { return (r & 3) + 8 * (r >> 2) + 4 * hi; }
__device__ __forceinline__ unsigned cvtpk(float lo, float hi) {
    unsigned r; asm volatile("v_cvt_pk_bf16_f32 %0, %1, %2" : "=v"(r) : "v"(lo), "v"(hi)); return r;
}
__device__ __forceinline__ bf16x8 pack8(f32x4 a, f32x4 b) {
    u32x4 w = {cvtpk(a[0], a[1]), cvtpk(a[2], a[3]), cvtpk(b[0], b[1]), cvtpk(b[2], b[3])};
    return *reinterpret_cast<bf16x8*>(&w);
}
template <class T> __device__ __forceinline__ bf16x8 load8(const T* p) {
    if constexpr (same_t<T, float>::v) { return pack8(*(const f32x4*)p, *(const f32x4*)(p + 4)); }
    else { return *reinterpret_cast<const bf16x8*>(p); }
}
__device__ __forceinline__ void mask_tile(f32x16& p0, f32x16& p1, int dq, unsigned W) {
    const float NEG = -__builtin_inff();
#pragma unroll
    for (int r = 0; r < 16; ++r) {
        const int c = (r & 3) + 8 * (r >> 2);
        if ((unsigned)(dq - c) >= W) p0[r] = NEG;
        if ((unsigned)(dq - c - 32) >= W) p1[r] = NEG;
    }
}
__device__ __forceinline__ void partialSM(f32x16& p0, f32x16& p1, float& m_reg, float& mn, float& alpha) {
    float pmax = p0[0]; for (int r = 1; r < 16; ++r) pmax = fmaxf(pmax, p0[r]); for (int r = 0; r < 16; ++r) pmax = fmaxf(pmax, p1[r]);
    { auto rr = __builtin_amdgcn_permlane32_swap(__float_as_uint(pmax), __float_as_uint(pmax), false, false);
      pmax = fmaxf(__uint_as_float(rr[0]), __uint_as_float(rr[1])); }
    constexpr float C2 = 1.4426950408889634f * SCALE;
    if (__builtin_expect(__all((pmax - m_reg) * SCALE <= THR), 1)) { mn = m_reg; alpha = 1.f; }
    else { mn = fmaxf(m_reg, pmax); alpha = __builtin_amdgcn_exp2f((m_reg - mn) * C2); m_reg = mn; }
    const float mnL = -mn * C2;
    for (int r = 0; r < 16; ++r) p0[r] = fmaf(p0[r], C2, mnL); for (int r = 0; r < 16; ++r) p1[r] = fmaf(p1[r], C2, mnL);
    for (int r = 0; r < 16; ++r) p0[r] = __builtin_amdgcn_exp2f(p0[r]);
}
__device__ __forceinline__ void finishSM(f32x16& p0, f32x16& p1, float alpha, float& l_reg, bf16x8& pa0, bf16x8& pa1, bf16x8& pa2, bf16x8& pa3) {
    for (int r = 0; r < 16; ++r) p1[r] = __builtin_amdgcn_exp2f(p1[r]);
    float ps = 0; for (int r = 0; r < 16; ++r) ps += p0[r]; for (int r = 0; r < 16; ++r) ps += p1[r];
    { auto rr = __builtin_amdgcn_permlane32_swap(__float_as_uint(ps), __float_as_uint(ps), false, false);
      ps = __uint_as_float(rr[0]) + __uint_as_float(rr[1]); }
    l_reg = l_reg * alpha + ps;
#define PK4(P, B_, OUT) do { unsigned a0 = cvtpk(P[B_+0], P[B_+1]), a1 = cvtpk(P[B_+2], P[B_+3]);                          \
        unsigned b0 = cvtpk(P[B_+4], P[B_+5]), b1 = cvtpk(P[B_+6], P[B_+7]);                                             \
        auto r0 = __builtin_amdgcn_permlane32_swap(a0, b0, false, false); auto r1 = __builtin_amdgcn_permlane32_swap(a1, b1, false, false); \
        u32x4 w = {r0[0], r1[0], r0[1], r1[1]}; OUT = *reinterpret_cast<bf16x8*>(&w); } while (0)
    PK4(p0, 0, pa0); PK4(p0, 8, pa1); PK4(p1, 0, pa2); PK4(p1, 8, pa3);
#undef PK4
}
template <int KB, bool SK>
__device__ __forceinline__ void qkt(f32x16& p0, f32x16& p1, const char* K_lds, int r32, int hi, const bf16x8* qr, bool act, const float* ck_l) {
    if (SK && !act) { const float NEG = -__builtin_inff();
#pragma unroll
        for (int r = 0; r < 16; ++r) { p0[r] = NEG; p1[r] = NEG; } return; }
    { const float* cb = ck_l + KB * 64 + 4 * hi;
#pragma unroll
      for (int g = 0; g < 4; ++g) { const f32x4 c0 = *(const f32x4*)(cb + 8 * g), c1 = *(const f32x4*)(cb + 32 + 8 * g);
#pragma unroll
          for (int e = 0; e < 4; ++e) { p0[4 * g + e] = c0[e]; p1[4 * g + e] = c1[e]; } } }
    const char* kb[4];
#pragma unroll
    for (int dd = 0; dd < 4; ++dd) kb[dd] = K_lds + KB * SHM_K + KSWZ(r32, (dd * 16 + hi * 8) * 2);
    bf16x8 kf0[8], kf1[8];
#pragma unroll
    for (int d0 = 0; d0 < 8; ++d0) { const char* a = kb[d0 & 3] + (d0 >> 2) * 128;
        kf0[d0] = *reinterpret_cast<const bf16x8*>(a); kf1[d0] = *reinterpret_cast<const bf16x8*>(a + 32 * 256); }
    asm volatile("s_waitcnt lgkmcnt(0)" ::: "memory"); SBAR();
#pragma unroll
    for (int d0 = 0; d0 < 8; ++d0) {
        p0 = __builtin_amdgcn_mfma_f32_32x32x16_bf16(kf0[d0], qr[d0], p0, 0, 0, 0);
        p1 = __builtin_amdgcn_mfma_f32_32x32x16_bf16(kf1[d0], qr[d0], p1, 0, 0, 0); }
}
template <int VB, bool SK>
__device__ __forceinline__ void pv_tile(f32x16* o, int vb0, bf16x8 pa0, bf16x8 pa1, bf16x8 pa2, bf16x8 pa3, bool act) {
    if (SK && !act) return;
#define TRRD(dst, off) asm volatile("ds_read_b64_tr_b16 %0, %1 offset:%2" : "=&v"(dst) : "v"(vb0), "i"(off) : "memory")
#define PV_D0(d0) do { s16x4 l0, l1, l2, l3, h0, h1, h2, h3; constexpr int b_ = VB * SHM_V + v_rd_off(d0, 0, 0);     \
        TRRD(l0, b_); TRRD(h0, b_ + 2048); TRRD(l1, b_ + 4096); TRRD(h1, b_ + 6144); TRRD(l2, b_ + 8192); TRRD(h2, b_ + 10240); TRRD(l3, b_ + 12288); TRRD(h3, b_ + 14336); \
        asm volatile("s_waitcnt lgkmcnt(0)" ::: "memory"); SBAR();                 \
        o[d0] = __builtin_amdgcn_mfma_f32_32x32x16_bf16(pa0, (bf16x8){l0[0], l0[1], l0[2], l0[3], h0[0], h0[1], h0[2], h0[3]}, o[d0], 0, 0, 0);   \
        o[d0] = __builtin_amdgcn_mfma_f32_32x32x16_bf16(pa1, (bf16x8){l1[0], l1[1], l1[2], l1[3], h1[0], h1[1], h1[2], h1[3]}, o[d0], 0, 0, 0);   \
        o[d0] = __builtin_amdgcn_mfma_f32_32x32x16_bf16(pa2, (bf16x8){l2[0], l2[1], l2[2], l2[3], h2[0], h2[1], h2[2], h2[3]}, o[d0], 0, 0, 0);   \
        o[d0] = __builtin_amdgcn_mfma_f32_32x32x16_bf16(pa3, (bf16x8){l3[0], l3[1], l3[2], l3[3], h3[0], h3[1], h3[2], h3[3]}, o[d0], 0, 0, 0); } while (0)
    PV_D0(0); PV_D0(1); PV_D0(2); PV_D0(3);
#undef PV_D0
#undef TRRD
}

struct PlainBlock { const bf16* Q; const bf16* K; const bf16* V; bf16* O; const float* C; int P0; };
__device__ __forceinline__ void attn_plain_block(const PlainBlock& B, char* lds, int wave_sgpr) {
    const int lane = mk_lane_id(), wid = wave_sgpr, tid = wid * 64 + lane, r32 = lane & 31, hi = lane >> 5;
    const int rbk = wid < 4 ? wid : 11 - wid;
    char* V_lds = lds; char* K_lds = lds + 2 * SHM_V;
    float* ws = (float*)(lds + 2 * SHM_V + 2 * SHM_K) + wid * 64; float* li_l = ws, * al_l = ws + 32; float* ck_l = (float*)(lds + LDS_CK);
    const int sr = tid >> 4, sc = (tid & 15) * 8, vst0 = v_st(sr, sc), vst1 = v_st(32 + sr, sc), kws = KSWZ(sr, sc * 2);
    const int vb0 = (int)(uintptr_t)V_lds + v_rd_base(lane);
    const int qlo = B.P0 + rbk * QBLK, qm = qlo + r32 - 4 * hi;
    const unsigned Wl = (unsigned)(qlo + r32 - (KMIN - 1));
    const int j_lo = KMIN / KVBLK, j_hi = (B.P0 + QB - 1) / KVBLK + 1, NT = j_hi - j_lo;
    bf16x8 qr[8];
#pragma unroll
    for (int d0 = 0; d0 < 8; ++d0) qr[d0] = load8<bf16>(B.Q + (size_t)(rbk * QBLK + r32) * RS + d0 * 16 + hi * 8);
    float m_reg = -1e30f, l_reg = 0.f; f32x16 o[4] = {};
    bf16x8 sk0, sk1, sv0, sv1; float scv;
#define PL_LOAD(k0) do { const bf16* kp_ = B.K + (size_t)((k0) + sr) * RS + sc; const bf16* vp_ = B.V + (size_t)((k0) + sr) * RS + sc; \
        sk0 = load8<bf16>(kp_); sk1 = load8<bf16>(kp_ + (size_t)32 * RS); sv0 = load8<bf16>(vp_); sv1 = load8<bf16>(vp_ + (size_t)32 * RS); scv = B.C[(k0) + lane]; } while (0)
#define PL_WRITE(bf) do { *(bf16x8*)(K_lds + (bf) * SHM_K + kws) = sk0; *(bf16x8*)(K_lds + (bf) * SHM_K + kws + 32 * 256) = sk1; \
        *(bf16x8*)(V_lds + (bf) * SHM_V + vst0) = sv0; *(bf16x8*)(V_lds + (bf) * SHM_V + vst1) = sv1; if (wid == 0) ck_l[(bf) * 64 + lane] = scv; } while (0)
#define PL_STEP(t, BUF) do { const int kb_ = (j_lo + NT - 1 - (t)) * KVBLK; const bool more_ = (t) + 1 < NT;                           \
        if (more_) PL_LOAD(kb_ - KVBLK);                                                                                                 \
        if (kb_ <= qlo + QBLK - 1) {                                                \
            f32x16 p0, p1; float mn, alpha; bf16x8 pa0, pa1, pa2, pa3;                                                                   \
            qkt<BUF, false>(p0, p1, K_lds, r32, hi, qr, true, ck_l);                                                                     \
            if (kb_ + KVBLK - 1 > qlo || kb_ < KMIN) mask_tile(p0, p1, qm - kb_, Wl);                                                    \
            partialSM(p0, p1, m_reg, mn, alpha);                                                                                         \
            if (__any(alpha < 1.f)) { if (hi == 0) al_l[r32] = alpha; asm volatile("s_waitcnt lgkmcnt(0)" ::: "memory");                 \
                _Pragma("unroll") for (int d_ = 0; d_ < 4; ++d_) _Pragma("unroll") for (int r = 0; r < 16; ++r) o[d_][r] *= al_l[crow(r, hi)]; } \
            finishSM(p0, p1, alpha, l_reg, pa0, pa1, pa2, pa3); SBAR();                                                                  \
            pv_tile<BUF, false>(o, vb0, pa0, pa1, pa2, pa3, true); }                                                                     \
        if (more_) PL_WRITE((BUF) ^ 1);                                                                                                  \
        __syncthreads(); } while (0)
    PL_LOAD((j_lo + NT - 1) * KVBLK); PL_WRITE(0);
    __syncthreads();
    _Pragma("nounroll") for (int t = 0; t < NT; t += 2) { PL_STEP(t, 0); if (t + 1 < NT) PL_STEP(t + 1, 1); }
    if (hi == 0) li_l[r32] = l_reg; asm volatile("s_waitcnt lgkmcnt(0)" ::: "memory");
    bf16* Ow = B.O + (size_t)(rbk * QBLK) * RS;
#pragma unroll
    for (int r = 0; r < 16; ++r) { const int orow = crow(r, hi); const float rl = __builtin_amdgcn_rcpf(li_l[orow]);
#pragma unroll
        for (int d0 = 0; d0 < 4; ++d0) { const float v = o[d0][r] * rl; const float vn = __shfl_xor(v, 1);
            if ((r32 & 1) == 0) *(unsigned*)(Ow + (size_t)orow * RS + d0 * 32 + r32) = cvtpk(v, vn); } }
    __syncthreads();
#undef PL_LOAD
#undef PL_WRITE
#undef PL_STEP
}
__device__ __forceinline__ void attn_dma_block(const PlainBlock& B, char* lds, int wave_sgpr) {
    const int lane = mk_lane_id(), wid = wave_sgpr, tid = wid * 64 + lane, r32 = lane & 31, hi = lane >> 5;
    const int rbk = wid < 4 ? wid : 11 - wid;
    char* V_lds = lds; char* K_lds = lds + 2 * SHM_V;
    float* ws = (float*)(lds + 2 * SHM_V + 2 * SHM_K) + wid * 64; float* li_l = ws, * al_l = ws + 32; float* ck_l = (float*)(lds + LDS_CK);
    unsigned koff[2], voff[2];
#pragma unroll
    for (int i = 0; i < 2; ++i) { const int j_ = 2 * wid + i, kr = 4 * j_ + (lane >> 4), kc = (lane & 15) ^ (kr & 7); koff[i] = (unsigned)(kr * (RS * 2) + kc * 16);
        const int st = 2 * j_ + (lane >> 5), kk = ((st >> 2) << 3) | ((lane & 31) >> 2), vk = (kk & ~0xC) | ((kk & 4) << 1) | ((kk & 8) >> 1), vc = (st & 3) * 32 + 8 * (lane & 3); voff[i] = (unsigned)(vk * (RS * 2) + vc * 2); }
    const unsigned kl0 = (unsigned)(uintptr_t)K_lds + (unsigned)wid * 2048u, vl0 = (unsigned)(uintptr_t)V_lds + (unsigned)wid * 2048u;
    const int vb0 = (int)(uintptr_t)V_lds + v_rd_base(lane);
    const int qlo = B.P0 + rbk * QBLK, qm = qlo + r32 - 4 * hi;
    const unsigned Wl = (unsigned)(qlo + r32 - (KMIN - 1));
    const int j_lo = KMIN / KVBLK, j_hi = (B.P0 + QB - 1) / KVBLK + 1, NT = j_hi - j_lo;
    bf16x8 qr[8];
#pragma unroll
    for (int d0 = 0; d0 < 8; ++d0) qr[d0] = load8<bf16>(B.Q + (size_t)(rbk * QBLK + r32) * RS + d0 * 16 + hi * 8);
    float m_reg = -1e30f, l_reg = 0.f; f32x16 o[4] = {};
    float scv;
#define PL_DMA(k0, bf) do { const char* kg_ = (const char*)(B.K + (size_t)(k0) * RS); const char* vg_ = (const char*)(B.V + (size_t)(k0) * RS);                           \
        _Pragma("unroll") for (int i_ = 0; i_ < 2; ++i_) {                                                                                                          \
            __builtin_amdgcn_global_load_lds((const unsigned*)(kg_ + koff[i_]), (__attribute__((address_space(3))) unsigned*)(uintptr_t)(kl0 + (bf) * SHM_K + i_ * 1024), 16, 0, 0); \
            __builtin_amdgcn_global_load_lds((const unsigned*)(vg_ + voff[i_]), (__attribute__((address_space(3))) unsigned*)(uintptr_t)(vl0 + (bf) * SHM_V + i_ * 1024), 16, 0, 0); } \
        scv = B.C[(k0) + lane]; } while (0)
#define PL_FIN(bf) do { if (wid == 0) ck_l[(bf) * 64 + lane] = scv; asm volatile("s_waitcnt vmcnt(0)" ::: "memory"); } while (0)
#define PL_STEP(t, BUF) do { const int kb_ = (j_lo + NT - 1 - (t)) * KVBLK; const bool more_ = (t) + 1 < NT;                           \
        if (more_) PL_DMA(kb_ - KVBLK, (BUF) ^ 1);                                                                                              \
        if (kb_ <= qlo + QBLK - 1) {                                                \
            f32x16 p0, p1; float mn, alpha; bf16x8 pa0, pa1, pa2, pa3;                                                                   \
            qkt<BUF, false>(p0, p1, K_lds, r32, hi, qr, true, ck_l);                                                                     \
            if (kb_ + KVBLK - 1 > qlo || kb_ < KMIN) mask_tile(p0, p1, qm - kb_, Wl);                                                    \
            partialSM(p0, p1, m_reg, mn, alpha);                                                                                         \
            if (__any(alpha < 1.f)) { if (hi == 0) al_l[r32] = alpha; asm volatile("s_waitcnt lgkmcnt(0)" ::: "memory");                 \
                _Pragma("unroll") for (int d_ = 0; d_ < 4; ++d_) _Pragma("unroll") for (int r = 0; r < 16; ++r) o[d_][r] *= al_l[crow(r, hi)]; } \
            finishSM(p0, p1, alpha, l_reg, pa0, pa1, pa2, pa3); SBAR();                                                                  \
            pv_tile<BUF, false>(o, vb0, pa0, pa1, pa2, pa3, true); }                                                                     \
        if (more_) PL_FIN((BUF) ^ 1);                                                                                                    \
        __syncthreads(); } while (0)
    PL_DMA((j_lo + NT - 1) * KVBLK, 0); PL_FIN(0);
    __syncthreads();
    _Pragma("nounroll") for (int t = 0; t < NT; t += 2) { PL_STEP(t, 0); if (t + 1 < NT) PL_STEP(t + 1, 1); }
    if (hi == 0) li_l[r32] = l_reg; asm volatile("s_waitcnt lgkmcnt(0)" ::: "memory");
    bf16* Ow = B.O + (size_t)(rbk * QBLK) * RS;
#pragma unroll
    for (int r = 0; r < 16; ++r) { const int orow = crow(r, hi); const float rl = __builtin_amdgcn_rcpf(li_l[orow]);
#pragma unroll
        for (int d0 = 0; d0 < 4; ++d0) { const float v = o[d0][r] * rl; const float vn = __shfl_xor(v, 1);
            if ((r32 & 1) == 0) *(unsigned*)(Ow + (size_t)orow * RS + d0 * 32 + r32) = cvtpk(v, vn); } }
    __syncthreads();
#undef PL_DMA
#undef PL_FIN
#undef PL_STEP
}
__device__ __forceinline__ void attn_pipe_block(const PlainBlock& B, char* lds, int wave_sgpr) {
    const int lane = mk_lane_id(), wid = wave_sgpr, tid = wid * 64 + lane, r32 = lane & 31, hi = lane >> 5;
    char* V_lds = lds; char* K_lds = lds + 2 * SHM_V;
    float* ws = (float*)(lds + 2 * SHM_V + 2 * SHM_K) + wid * 64; float* li_l = ws, * al_l = ws + 32; float* ck_l = (float*)(lds + LDS_CK);
    const int sr = tid >> 4, sc = (tid & 15) * 8, vst0 = v_st(sr, sc), vst1 = v_st(32 + sr, sc), kws = KSWZ(sr, sc * 2);
    const int vb0 = (int)(uintptr_t)V_lds + v_rd_base(lane);
    const int qlo = B.P0 + wid * QBLK, qm = qlo + r32 - 4 * hi;
    const unsigned Wl = (unsigned)(qlo + r32 - (KMIN - 1));
    const int j_lo = KMIN / KVBLK, j_hi = (B.P0 + QB - 1) / KVBLK + 1, NT = j_hi - j_lo;
    bf16x8 qr[8];
#pragma unroll
    for (int d0 = 0; d0 < 8; ++d0) qr[d0] = load8<bf16>(B.Q + (size_t)(wid * QBLK + r32) * RS + d0 * 16 + hi * 8);
    float m_reg = -1e30f, l_reg = 0.f; f32x16 o[4] = {};
    bf16x8 sk0, sk1, sv0, sv1; float scv;
#define PP_LOADK(k0) do { const bf16* kp_ = B.K + (size_t)((k0) + sr) * RS + sc; sk0 = load8<bf16>(kp_); sk1 = load8<bf16>(kp_ + (size_t)32 * RS); scv = B.C[(k0) + lane]; } while (0)
#define PP_LOADV(k0) do { const bf16* vp_ = B.V + (size_t)((k0) + sr) * RS + sc; sv0 = load8<bf16>(vp_); sv1 = load8<bf16>(vp_ + (size_t)32 * RS); } while (0)
#define PP_WRITEK(bf) do { *(bf16x8*)(K_lds + (bf) * SHM_K + kws) = sk0; *(bf16x8*)(K_lds + (bf) * SHM_K + kws + 32 * 256) = sk1; if (wid == 0) ck_l[(bf) * 64 + lane] = scv; } while (0)
#define PP_WRITEV(bf) do { *(bf16x8*)(V_lds + (bf) * SHM_V + vst0) = sv0; *(bf16x8*)(V_lds + (bf) * SHM_V + vst1) = sv1; } while (0)
#define PP_KB(t) ((j_lo + (t)) * KVBLK)
#define PP_ACT(t) (PP_KB(t) <= qlo + QBLK - 1)
    PP_LOADK(PP_KB(0)); PP_LOADV(PP_KB(0)); PP_WRITEK(0); PP_WRITEV(0);
    if (NT > 1) { PP_LOADK(PP_KB(1)); PP_WRITEK(1); }
    __syncthreads();
    f32x16 pA0, pA1, pB0, pB1;
    qkt<0, false>(pA0, pA1, K_lds, r32, hi, qr, true, ck_l);
    __syncthreads();
#define PP_STEP(t, BUF, PC0, PC1, PN0, PN1) do { const int kb_ = PP_KB(t);                                                              \
        if ((t) + 2 < NT) PP_LOADK(PP_KB((t) + 2));                                                                                     \
        if ((t) + 1 < NT) PP_LOADV(PP_KB((t) + 1));                                                                                     \
        if ((t) + 1 < NT) qkt<(BUF) ^ 1, false>(PN0, PN1, K_lds, r32, hi, qr, true, ck_l);                           \
        {                                                                                                                               \
            float mn, alpha; bf16x8 pa0, pa1, pa2, pa3;                                                                                 \
            if (kb_ + KVBLK - 1 > qlo || kb_ < KMIN) mask_tile(PC0, PC1, qm - kb_, Wl);                                                 \
            partialSM(PC0, PC1, m_reg, mn, alpha);                                                                                      \
            if (__any(alpha < 1.f)) { if (hi == 0) al_l[r32] = alpha; asm volatile("s_waitcnt lgkmcnt(0)" ::: "memory");                \
                _Pragma("unroll") for (int d_ = 0; d_ < 4; ++d_) _Pragma("unroll") for (int r = 0; r < 16; ++r) o[d_][r] *= al_l[crow(r, hi)]; } \
            finishSM(PC0, PC1, alpha, l_reg, pa0, pa1, pa2, pa3); SBAR();                                                               \
            pv_tile<BUF, false>(o, vb0, pa0, pa1, pa2, pa3, true); }                                                                    \
        if ((t) + 2 < NT) PP_WRITEK(BUF);                                                                                               \
        if ((t) + 1 < NT) PP_WRITEV((BUF) ^ 1);                                                                                         \
        __syncthreads(); } while (0)
    _Pragma("nounroll") for (int t = 0; t < NT; t += 2) { PP_STEP(t, 0, pA0, pA1, pB0, pB1); if (t + 1 < NT) PP_STEP(t + 1, 1, pB0, pB1, pA0, pA1); }
    if (hi == 0) li_l[r32] = l_reg; asm volatile("s_waitcnt lgkmcnt(0)" ::: "memory");
    bf16* Ow = B.O + (size_t)(wid * QBLK) * RS;
#pragma unroll
    for (int r = 0; r < 16; ++r) { const int orow = crow(r, hi); const float rl = __builtin_amdgcn_rcpf(li_l[orow]);
#pragma unroll
        for (int d0 = 0; d0 < 4; ++d0) { const float v = o[d0][r] * rl; const float vn = __shfl_xor(v, 1);
            if ((r32 & 1) == 0) *(unsigned*)(Ow + (size_t)orow * RS + d0 * 32 + r32) = cvtpk(v, vn); } }
    __syncthreads();
#undef PP_LOADK
#undef PP_LOADV
#undef PP_WRITEK
#undef PP_WRITEV
#undef PP_KB
#undef PP_ACT
#undef PP_STEP
}
constexpr int P2_WS = 131072 + 2048, P2_CK = P2_WS + NW * 64 * 4;
__device__ __forceinline__ void attn_plain2_block(const PlainBlock& B, char* lds, int wave_sgpr) {
    const int lane = mk_lane_id(), wid = wave_sgpr, tid = wid * 64 + lane, r32 = lane & 31, hi = lane >> 5;
    char* V_lds = lds; char* K_lds = lds + 4 * SHM_V;
    float* ws = (float*)(lds + P2_WS) + wid * 64; float* li_l = ws, * al_l = ws + 32; float* ck_l = (float*)(lds + P2_CK);
    const int sr = tid >> 4, sc = (tid & 15) * 8, vst0 = v_st(sr, sc), vst1 = v_st(32 + sr, sc), kws = KSWZ(sr, sc * 2);
    const int vb0 = (int)(uintptr_t)V_lds + v_rd_base(lane);
    const int qlo = B.P0 + wid * QBLK, qm = qlo + r32 - 4 * hi;
    const unsigned Wl = (unsigned)(qlo + r32 - (KMIN - 1));
    const int j_lo = KMIN / KVBLK, j_hi = (B.P0 + QB - 1) / KVBLK + 1, NT = j_hi - j_lo, NS = (NT + 1) >> 1;
    bf16x8 qr[8];
#pragma unroll
    for (int d0 = 0; d0 < 8; ++d0) qr[d0] = load8<bf16>(B.Q + (size_t)(wid * QBLK + r32) * RS + d0 * 16 + hi * 8);
    float m_reg = -1e30f, l_reg = 0.f; f32x16 o[4] = {};
    bf16x8 ak0, ak1, av0, av1, bk0, bk1, bv0, bv1; float ac, bc;
#define Q2_LOAD(tt, K0, K1, V0, V1, CB_) do { const int t_ = (tt) < NT ? (tt) : NT - 1; const int k0_ = (j_lo + t_) * KVBLK;                              \
        const bf16* kp_ = B.K + (size_t)(k0_ + sr) * RS + sc; const bf16* vp_ = B.V + (size_t)(k0_ + sr) * RS + sc;                                   \
        K0 = load8<bf16>(kp_); K1 = load8<bf16>(kp_ + (size_t)32 * RS); V0 = load8<bf16>(vp_); V1 = load8<bf16>(vp_ + (size_t)32 * RS); CB_ = B.C[k0_ + lane]; } while (0)
#define Q2_WRITE(bf, K0, K1, V0, V1, CB_) do { *(bf16x8*)(K_lds + (bf) * SHM_K + kws) = K0; *(bf16x8*)(K_lds + (bf) * SHM_K + kws + 32 * 256) = K1;     \
        *(bf16x8*)(V_lds + (bf) * SHM_V + vst0) = V0; *(bf16x8*)(V_lds + (bf) * SHM_V + vst1) = V1; if (wid == 0) ck_l[(bf) * 64 + lane] = CB_; } while (0)
#define Q2_TILE(tt, BUF) do { const int kb_ = (j_lo + (tt)) * KVBLK;                                                                                 \
        if ((tt) < NT && kb_ <= qlo + QBLK - 1) {                                                                                                    \
            f32x16 p0, p1; float mn, alpha; bf16x8 pa0, pa1, pa2, pa3;                                                                               \
            qkt<BUF, false>(p0, p1, K_lds, r32, hi, qr, true, ck_l);                                                                                 \
            if (kb_ + KVBLK - 1 > qlo || kb_ < KMIN) mask_tile(p0, p1, qm - kb_, Wl);                                                                \
            partialSM(p0, p1, m_reg, mn, alpha);                                                                                                     \
            if (__any(alpha < 1.f)) { if (hi == 0) al_l[r32] = alpha; asm volatile("s_waitcnt lgkmcnt(0)" ::: "memory");                             \
                _Pragma("unroll") for (int d_ = 0; d_ < 4; ++d_) _Pragma("unroll") for (int r = 0; r < 16; ++r) o[d_][r] *= al_l[crow(r, hi)]; }     \
            finishSM(p0, p1, alpha, l_reg, pa0, pa1, pa2, pa3); SBAR();                                                                              \
            pv_tile<BUF, false>(o, vb0, pa0, pa1, pa2, pa3, true); } } while (0)
#define Q2_STEP(s_, PB) do {                                                                                                                         \
        Q2_LOAD(2 * (s_) + 2, ak0, ak1, av0, av1, ac); Q2_LOAD(2 * (s_) + 3, bk0, bk1, bv0, bv1, bc);                                                 \
        Q2_TILE(2 * (s_), 2 * (PB)); Q2_TILE(2 * (s_) + 1, 2 * (PB) + 1);                                                                            \
        if (2 * (s_) + 2 < NT) { Q2_WRITE(2 * ((PB) ^ 1), ak0, ak1, av0, av1, ac); if (2 * (s_) + 3 < NT) Q2_WRITE(2 * ((PB) ^ 1) + 1, bk0, bk1, bv0, bv1, bc); } \
        __syncthreads(); } while (0)
    Q2_LOAD(0, ak0, ak1, av0, av1, ac); Q2_LOAD(1, bk0, bk1, bv0, bv1, bc);
    Q2_WRITE(0, ak0, ak1, av0, av1, ac); if (NT > 1) Q2_WRITE(1, bk0, bk1, bv0, bv1, bc);
    __syncthreads();
    _Pragma("nounroll") for (int s = 0; s < NS; s += 2) { Q2_STEP(s, 0); if (s + 1 < NS) Q2_STEP(s + 1, 1); }
    if (hi == 0) li_l[r32] = l_reg; asm volatile("s_waitcnt lgkmcnt(0)" ::: "memory");
    bf16* Ow = B.O + (size_t)(wid * QBLK) * RS;
#pragma unroll
    for (int r = 0; r < 16; ++r) { const int orow = crow(r, hi); const float rl = __builtin_amdgcn_rcpf(li_l[orow]);
#pragma unroll
        for (int d0 = 0; d0 < 4; ++d0) { const float v = o[d0][r] * rl; const float vn = __shfl_xor(v, 1);
            if ((r32 & 1) == 0) *(unsigned*)(Ow + (size_t)orow * RS + d0 * 32 + r32) = cvtpk(v, vn); } }
    __syncthreads();
#undef Q2_LOAD
#undef Q2_WRITE
#undef Q2_TILE
#undef Q2_STEP
}
}
namespace rt {
#define RT_LAS __attribute__((address_space(3)))
typedef short bf16x8 __attribute__((ext_vector_type(8)));
typedef short s16x4 __attribute__((ext_vector_type(4)));
typedef float f32x16 __attribute__((ext_vector_type(16)));
typedef unsigned u32x4 __attribute__((ext_vector_type(4)));
typedef unsigned u32x2 __attribute__((ext_vector_type(2)));
__device__ __forceinline__ unsigned off_b(unsigned row, unsigned ch) { return 256u * row + 16u * (ch ^ (((row & 3u) << 2) | ((row >> 2) & 3u))); }
__device__ __forceinline__ unsigned cvtpk(float lo, float hi) { unsigned r; asm volatile("v_cvt_pk_bf16_f32 %0, %1, %2" : "=v"(r) : "v"(lo), "v"(hi)); return r; }
__device__ __forceinline__ bf16x8 rowfrag(RT_LAS const char* tile, unsigned row0, unsigned s, unsigned lane) {
    return *(RT_LAS const bf16x8*)(tile + off_b(row0 + (lane & 31u), 2u * s + (lane >> 5)));
}
__device__ __forceinline__ unsigned trbase(unsigned lane, unsigned c) {
    const unsigned h = lane >> 5, blk = (lane >> 4) & 1u, q = (lane & 15u) >> 2, p = lane & 3u;
    return off_b(8u * h + q, 4u * c + 2u * blk + (p >> 1)) + 8u * (p & 1u);
}
__device__ __forceinline__ bf16x8 trfrag(RT_LAS const char* tile, unsigned base, unsigned ks) {
    const s16x4 lo = __builtin_amdgcn_ds_read_tr16_b64_v4i16((RT_LAS s16x4*)(tile + base + 4096u * ks));
    const s16x4 hi = __builtin_amdgcn_ds_read_tr16_b64_v4i16((RT_LAS s16x4*)(tile + (base ^ 16u) + 1024u + 4096u * ks));
    return (bf16x8){lo[0], lo[1], lo[2], lo[3], hi[0], hi[1], hi[2], hi[3]};
}
#define RT_PK4(P, B_, OUT) do { unsigned a0_ = cvtpk(P[B_+0], P[B_+1]), a1_ = cvtpk(P[B_+2], P[B_+3]); unsigned b0_ = cvtpk(P[B_+4], P[B_+5]), b1_ = cvtpk(P[B_+6], P[B_+7]); \
        auto r0_ = __builtin_amdgcn_permlane32_swap(a0_, b0_, false, false); auto r1_ = __builtin_amdgcn_permlane32_swap(a1_, b1_, false, false); \
        u32x4 w_ = {r0_[0], r1_[0], r0_[1], r1_[1]}; OUT = *reinterpret_cast<bf16x8*>(&w_); } while (0)
#define RT_MFMA(a, b, c) __builtin_amdgcn_mfma_f32_32x32x16_bf16(a, b, c, 0, 0, 0)
#define RT_WAIT() do { asm volatile("s_waitcnt lgkmcnt(0)" ::: "memory"); __builtin_amdgcn_sched_barrier(0); } while (0)

__device__ __forceinline__ void phase_retention(const unsigned short* Q, const unsigned short* K, unsigned short* V, RT_LAS unsigned char* lds_u, int nb, int lp, int wave_sgpr, bool dry = false) {
    RT_LAS char* Kimg = (RT_LAS char*)lds_u; RT_LAS char* Vimg = Kimg + 65536; RT_LAS char* Timg = Kimg + 98304;
    const unsigned lane = (unsigned)mk_lane_id(), wid = (unsigned)wave_sgpr, tid = wid * 64u + lane, r32 = lane & 31u, hi = lane >> 5;
    const unsigned ib = wid < 4u ? wid >> 1 : 3u - ((wid - 4u) >> 1), eb = wid & 1u;
    const int nchunk = lp / 128;
    _Pragma("nounroll") for (int unit = blockIdx.x; unit < nb * 64; unit += gridDim.x) {
        int bh, es; if ((gridDim.x & 7) == 0 && nb * 8 == 32) { const int cls = unit & 7, r = (unit >> 3) & 31; bh = cls * 4 + (r >> 3); es = r & 7; } else { bh = unit >> 3; es = unit & 7; }
        const int b = bh >> 3, h = bh & 7;
        const float l2g = __log2f(1.0f - exp2f(-5.0f - (float)h)), gC = exp2f(128.0f * l2g);
        const float rowfac = exp2f(((float)(32u * ib + r32) - 127.0f) * l2g);
        f32x16 ST0 = {}, ST1 = {};
        __syncthreads();
        { u32x4 z = {0u, 0u, 0u, 0u};
#pragma unroll
          for (int i = 0; i < 4; ++i) *(RT_LAS u32x4*)(Timg + (tid + 512u * i) * 16u) = z; }
        u32x4 kpre[8], vpre[2]; bf16x8 qr[16];
#define RT_LOAD_KV(rb_) do { const char* kb_ = (const char*)(K + (rb_) * 2048 + h * 256); const char* vb_ = (const char*)(V + (rb_) * 4096 + h * 512 + es * 64);     \
        unsigned t_ = tid; asm volatile("" : "+v"(t_));     \
        const unsigned ko_ = (t_ >> 5) * 4096u + (t_ & 31u) * 16u, vo_ = (t_ >> 3) * 8192u + (t_ & 7u) * 16u; \
        _Pragma("unroll") for (int i = 0; i < 8; ++i) kpre[i] = *(const u32x4*)(kb_ + (size_t)i * 65536 + ko_); \
        _Pragma("unroll") for (int i = 0; i < 2; ++i) vpre[i] = *(const u32x4*)(vb_ + (size_t)i * 524288 + vo_); } while (0)
#define RT_LOAD_Q(rb_) do { const char* qb_ = (const char*)(Q + ((((rb_) + 32u * ib) >> 5) * 8 + h) * (size_t)8192); unsigned l_ = lane; asm volatile("" : "+v"(l_)); _Pragma("unroll") for (int s = 0; s < 16; ++s) qr[s] = *(const bf16x8*)(qb_ + 1024 * s + 16u * l_); } while (0)
#define RT_LOAD_QH(rb_, h0_) do { const char* qb_ = (const char*)(Q + ((((rb_) + 32u * ib) >> 5) * 8 + h) * (size_t)8192); unsigned l_ = lane; asm volatile("" : "+v"(l_)); _Pragma("unroll") for (int s = 0; s < 8; ++s) qr[8 * (h0_) + s] = *(const bf16x8*)(qb_ + 1024 * (8 * (h0_) + s) + 16u * l_); } while (0)
        { const size_t rb0 = (size_t)b * lp; RT_LOAD_KV(rb0); RT_LOAD_Q(rb0); }
        _Pragma("nounroll") for (int c = 0; c < nchunk; ++c) {
            const size_t rowbase = (size_t)b * lp + (size_t)c * 128;
            __syncthreads();
#pragma unroll
            for (int i = 0; i < 8; ++i) { const unsigned idx = tid + 512u * i, j = idx >> 5, ch = idx & 31u;
                *(RT_LAS u32x4*)(Kimg + (ch >> 4) * 32768u + off_b(j, ch & 15u)) = kpre[i]; }
#pragma unroll
            for (int i = 0; i < 2; ++i) { const unsigned idx = tid + 512u * i, j = idx >> 3, ch = idx & 7u;
                *(RT_LAS u32x4*)(Vimg + off_b(j, ch)) = vpre[i]; }
            __syncthreads();
            f32x16 acc0 = {}, acc1 = {};
            unsigned lo_ = lane; asm volatile("" : "+v"(lo_));
            const unsigned v0b = trbase(lo_, 0u), v1b = trbase(lo_, 1u), tbase0 = trbase(lo_, eb), tbase1 = trbase(lo_, 2u + eb);
#pragma unroll
            for (unsigned jb = 0; jb < 4; ++jb) if (jb <= ib && (jb & 1u) == eb) {
                f32x16 sp = {};
#pragma unroll
                for (unsigned hh = 0; hh < 2; ++hh) { bf16x8 kf[8];
#pragma unroll
                    for (unsigned s = 0; s < 8; ++s) kf[s] = rowfrag(Kimg + hh * 32768u, 32u * jb, s, lo_);
                    RT_WAIT();
#pragma unroll
                    for (unsigned s = 0; s < 8; ++s) sp = RT_MFMA(kf[s], qr[8u * hh + s], sp);
                    __builtin_amdgcn_sched_barrier(0); }
                if (jb == ib) {
#pragma unroll
                    for (unsigned r = 0; r < 16; ++r) if ((r & 3u) + 8u * (r >> 2) + 4u * hi > r32) sp[r] = 0.f;
                }
                bf16x8 pa0, pa1; RT_PK4(sp, 0, pa0); RT_PK4(sp, 8, pa1);
                const bf16x8 va0 = trfrag(Vimg, v0b, 2u * jb), va1 = trfrag(Vimg, v0b, 2u * jb + 1u), vb0 = trfrag(Vimg, v1b, 2u * jb), vb1 = trfrag(Vimg, v1b, 2u * jb + 1u);
                RT_WAIT();
                acc0 = RT_MFMA(va0, pa0, acc0); acc0 = RT_MFMA(va1, pa1, acc0); acc1 = RT_MFMA(vb0, pa0, acc1); acc1 = RT_MFMA(vb1, pa1, acc1);
                __builtin_amdgcn_sched_barrier(0);
            }
#define RT_POST(OTH) do { RT_LAS char* xs = (RT_LAS char*)lds_u + 133120u + wid * 2048u + lane * 32u;        \
              u32x4 w0 = {cvtpk(OTH[0], OTH[1]), cvtpk(OTH[2], OTH[3]), cvtpk(OTH[4], OTH[5]), cvtpk(OTH[6], OTH[7])}, w1 = {cvtpk(OTH[8], OTH[9]), cvtpk(OTH[10], OTH[11]), cvtpk(OTH[12], OTH[13]), cvtpk(OTH[14], OTH[15])}; \
              *(RT_LAS u32x4*)xs = w0; *(RT_LAS u32x4*)(xs + 16) = w1; } while (0)
#define RT_CROSS(ACC) do { _Pragma("unroll") for (unsigned hh = 0; hh < 2; ++hh) { bf16x8 tf[8]; _Pragma("unroll") for (unsigned s = 0; s < 8; ++s) tf[s] = trfrag(Timg, hh ? tbase1 : tbase0, s); RT_WAIT(); \
              _Pragma("unroll") for (unsigned s = 0; s < 8; ++s) ACC = RT_MFMA(tf[s], qr[8u * hh + s], ACC); __builtin_amdgcn_sched_barrier(0); \
              RT_LOAD_QH(rbq_, hh); __builtin_amdgcn_sched_barrier(0); } } while (0)
#define RT_FINISH(ACC) do { unsigned lu2_ = lane; asm volatile("" : "+v"(lu2_)); const RT_LAS char* xp = (const RT_LAS char*)lds_u + 133120u + (wid ^ 1u) * 2048u + lane * 32u; \
              const u32x4 w0 = *(const RT_LAS u32x4*)xp, w1 = *(const RT_LAS u32x4*)(xp + 16); \
              _Pragma("unroll") for (int k = 0; k < 4; ++k) { ACC[2 * k] += __builtin_bit_cast(float, w0[k] << 16); ACC[2 * k + 1] += __builtin_bit_cast(float, w0[k] & 0xffff0000u); \
                  ACC[8 + 2 * k] += __builtin_bit_cast(float, w1[k] << 16); ACC[8 + 2 * k + 1] += __builtin_bit_cast(float, w1[k] & 0xffff0000u); } \
              if (!dry || rowfac < 0.f) { unsigned short* yp = (unsigned short*)((char*)(V + (rowbase + 32u * ib) * 4096 + h * 512 + es * 64 + 32u * eb) + ((lu2_ & 31u) * 8192u + (lu2_ >> 5) * 16u)); \
                \
              unsigned gx[4], gy[4]; _Pragma("unroll") for (int g = 0; g < 4; ++g) { gx[g] = cvtpk(ACC[4 * g] * rowfac, ACC[4 * g + 1] * rowfac); gy[g] = cvtpk(ACC[4 * g + 2] * rowfac, ACC[4 * g + 3] * rowfac); } \
              _Pragma("unroll") for (int p = 0; p < 2; ++p) { auto sx = __builtin_amdgcn_permlane32_swap(gx[2 * p], gx[2 * p + 1], false, false); auto sy = __builtin_amdgcn_permlane32_swap(gy[2 * p], gy[2 * p + 1], false, false); \
                  u32x4 w = {sx[0], sy[0], sx[1], sy[1]}; *(u32x4*)(yp + 16 * p) = w; } } } while (0)
            if (eb) { const f32x16 t_ = acc0; acc0 = acc1; acc1 = t_; }
            RT_POST(acc1);
            { const size_t rbn = (c + 1 < nchunk) ? rowbase + 128 : rowbase; RT_LOAD_KV(rbn); }
            const size_t rbq_ = (c + 1 < nchunk) ? rowbase + 128 : rowbase;
            RT_CROSS(acc0);
            __syncthreads();
            RT_FINISH(acc0);
            unsigned lu_ = lane; asm volatile("" : "+v"(lu_));
            const unsigned kbase = trbase(lu_, wid & 3u), v0base = trbase(lu_, 0u), v1base = trbase(lu_, 1u);
#pragma unroll
            for (unsigned g4 = 0; g4 < 4; ++g4) { bf16x8 bk[2], ua[2], ub[2];
#pragma unroll
                for (unsigned k = 0; k < 2; ++k) { bk[k] = trfrag(Kimg + (wid >> 2) * 32768u, kbase, 2u * g4 + k); ua[k] = trfrag(Vimg, v0base, 2u * g4 + k); ub[k] = trfrag(Vimg, v1base, 2u * g4 + k); }
                RT_WAIT();
#pragma unroll
                for (unsigned k = 0; k < 2; ++k) { ST0 = RT_MFMA(ua[k], bk[k], ST0); ST1 = RT_MFMA(ub[k], bk[k], ST1); }
                __builtin_amdgcn_sched_barrier(0); }
            ST0 = ST0 * gC; ST1 = ST1 * gC;
            { const unsigned drow = 32u * (wid & 3u) + r32, chb = 8u * (wid >> 2);
#pragma unroll
              for (unsigned g = 0; g < 4; ++g) { u32x2 w0, w1;
                  w0.x = cvtpk(ST0[4 * g], ST0[4 * g + 1]); w0.y = cvtpk(ST0[4 * g + 2], ST0[4 * g + 3]);
                  w1.x = cvtpk(ST1[4 * g], ST1[4 * g + 1]); w1.y = cvtpk(ST1[4 * g + 2], ST1[4 * g + 3]);
                  *(RT_LAS u32x2*)(Timg + off_b(drow, chb + g) + 8u * hi) = w0;
                  *(RT_LAS u32x2*)(Timg + off_b(drow, chb + 4u + g) + 8u * hi) = w1; } }
        }
    }
}
#undef RT_PK4
#undef RT_POST
#undef RT_CROSS
#undef RT_FINISH
#undef RT_LOAD_KV
#undef RT_LOAD_Q
#undef RT_LOAD_QH
#undef RT_MFMA
#undef RT_WAIT
}
#ifndef MK_ONE_LAUNCH
#define MK_ONE_LAUNCH 1
#endif
constexpr int NB = 4, SEQ = 4096, DM = 2048, NMETA = 16, PADR = 112, LP = 4224, MROWS = NB * LP;
constexpr int RH = 8, RDK = 256, RDV = 512, RVW = 4096, RNIN = 12288;
constexpr int FH = 16, FDH = 128, FNIN = 6160, FNQKV = 6144;
constexpr int NEXP = 32, FFD = 512, MAXSLOT = 40960;
constexpr float RMS_EPS = 1e-6f, GN_EPS = 1e-6f;
constexpr int NWAVES = 8, NTHREADS = 512;

constexpr size_t MiB = 1u << 20;
constexpr size_t WS_CTL = 0, CTL_ZERO_BYTES = 65536;
constexpr size_t WS_TOKE = 1 * MiB, WS_TOKP = WS_TOKE + 256 * 1024, WS_TOKW = WS_TOKP + 256 * 1024, WS_SLOT = WS_TOKW + 256 * 1024;
constexpr size_t WS_CW = 2 * MiB;
constexpr size_t WS_TILEE = 2 * MiB + 512 * 1024;
constexpr size_t WS_LF = 3 * MiB, WS_CC = 5 * MiB, WS_CCS = 6 * MiB + 512 * 1024;
constexpr size_t WS_ROPE = 8 * MiB;
constexpr size_t WS_WRGT = 13 * MiB;
constexpr size_t WS_WRET = 13 * MiB + 128 * 1024;
constexpr size_t WS_WFT = 14 * MiB;
constexpr size_t WS_WRI = 16 * MiB, WS_WRO = 64 * MiB, WS_WFI = 80 * MiB, WS_WFO = 104 * MiB, WS_WGU = 112 * MiB, WS_WDN = 240 * MiB;
constexpr size_t WS_H = 304 * MiB, WS_HN = 436 * MiB, WS_R1 = 502 * MiB, WS_R2 = 700 * MiB;
constexpr int HOLE_MOE0 = 5760, HOLE_MOE1 = 8320;
constexpr int TOKCAP = 16896;
constexpr size_t WS_TOKROW = 964 * MiB, WS_TOKWT = 967 * MiB, WS_END = 970 * MiB;
constexpr size_t ACT_BYTES = (size_t)MROWS * DM * 2;
static_assert(ACT_BYTES == 66 * MiB, "act size");
constexpr int CW_BAR = 4096, CW_CNT = 8192;

#define GAS __attribute__((address_space(1)))
#define LAS __attribute__((address_space(3)))
typedef unsigned short bf16;
typedef unsigned v4u __attribute__((ext_vector_type(4)));
typedef unsigned v2u __attribute__((ext_vector_type(2)));
typedef float f32x4 __attribute__((ext_vector_type(4)));
typedef float f32x2 __attribute__((ext_vector_type(2)));
typedef short bf16x8 __attribute__((ext_vector_type(8)));
typedef _Float16 h16x4 __attribute__((ext_vector_type(4)));
typedef _Float16 h16x8 __attribute__((ext_vector_type(8)));
constexpr int ROUTE_MAXENT = 160;
constexpr int LDS_ROUTE_OFF = 131072 + 2048 + 16384;
constexpr int LDS_WRG_OFF = 131072 + 2048;
#define LDS_WAIT() asm volatile("s_waitcnt lgkmcnt(0)" ::: "memory")
#define VM_WAIT() asm volatile("s_waitcnt vmcnt(0)" ::: "memory")
__device__ __forceinline__ unsigned f2bf(float f) { unsigned u = __builtin_bit_cast(unsigned, f); return (u + 0x7fffu + ((u >> 16) & 1u)) >> 16; }
__device__ __forceinline__ unsigned pk2(float lo, float hi) { unsigned r; asm volatile("v_cvt_pk_bf16_f32 %0, %1, %2" : "=v"(r) : "v"(lo), "v"(hi)); return r; }
__device__ __forceinline__ float bflo(unsigned w) { return __builtin_bit_cast(float, w << 16); }
__device__ __forceinline__ float bfhi(unsigned w) { return __builtin_bit_cast(float, w & 0xffff0000u); }
__device__ __forceinline__ float bf2f(bf16 b) { return __builtin_bit_cast(float, (unsigned)b << 16); }
__device__ __forceinline__ float wave_sum(float v) {
#pragma unroll
    for (int o = 1; o < 64; o <<= 1) v += __shfl_xor(v, o);
    return v;
}

#define XB_TMO      128
#define XB_XCNT(j)  (256  + 64 * (j))
#define XB_XSUB(j)  (1280 + 64 * (j))
#define XB_XGEN(j)  (2304 + 64 * (j))
#define XB_TOP      3328
#define XB_TOPGEN   3392
#define XCD_BAR_WORDS 3456
#define XB_SPIN_CAP (1u << 24)
__device__ __forceinline__ unsigned xb_ld(unsigned* p)              { return __hip_atomic_load(p, __ATOMIC_RELAXED, __HIP_MEMORY_SCOPE_AGENT); }
__device__ __forceinline__ unsigned xb_add(unsigned* p, unsigned v) { return __hip_atomic_fetch_add(p, v, __ATOMIC_RELAXED, __HIP_MEMORY_SCOPE_AGENT); }
__device__ __forceinline__ unsigned xb_xcc_id() { return (unsigned)__builtin_amdgcn_s_getreg((3 << 11) | 20) & 0xFu; }
#define XB_SPIN(cond, bar) do { unsigned _sp = 0; while (cond) { __builtin_amdgcn_s_sleep(1); \
    if ((++_sp & 255u) == 0u) { if (xb_ld(&(bar)[XB_TMO])) break; if (_sp > XB_SPIN_CAP) { atomicAdd(&(bar)[XB_TMO], 1u); break; } } } } while (0)
struct XcdBarrier { unsigned* bar; unsigned x; volatile LAS unsigned* st; int wave; };
__device__ __forceinline__ XcdBarrier xcd_barrier_post(unsigned* bar, volatile LAS unsigned* st, int wave) {
    XcdBarrier b; b.bar = bar; b.x = xb_xcc_id(); b.st = st; b.wave = wave;
    if (wave == 0 && mk_lane_id() == 0) (void)xb_add(&bar[XB_XCNT(b.x)], 1u);
    return b;
}
__device__ __forceinline__ void xcd_barrier_complete(unsigned* bar, unsigned x, unsigned& nloc, unsigned& nx) {
    const unsigned G = gridDim.x * gridDim.y * gridDim.z;
    unsigned sum, cnt, mine, sp = 0u;
    for (;;) {
        sum = 0u; cnt = 0u; mine = 0u;
#pragma unroll
        for (unsigned j = 0; j < 16; ++j) { const unsigned c = xb_ld(&bar[XB_XCNT(j)]); sum += c; cnt += (c > 0u) ? 1u : 0u; mine = (j == x) ? c : mine; }
        if (sum == G) break;
        __builtin_amdgcn_s_sleep(1);
        if ((++sp & 255u) == 0u) { if (xb_ld(&bar[XB_TMO])) break; if (sp > XB_SPIN_CAP) { atomicAdd(&bar[XB_TMO], 1u); break; } }
    }
    nloc = mine > 0u ? mine : 1u; nx = cnt > 0u ? cnt : 1u;
}
__device__ __forceinline__ void xcd_barrier(const XcdBarrier& b) {
    asm volatile("s_waitcnt vmcnt(0)" ::: "memory");
    __syncthreads();
    if (b.wave == 0 && mk_lane_id() == 0) {
        unsigned* bar = b.bar;
        __builtin_amdgcn_s_waitcnt(0);
        unsigned nloc = b.st[0], nx = b.st[1];
        if (nloc == 0u) { xcd_barrier_complete(bar, b.x, nloc, nx); b.st[0] = nloc; b.st[1] = nx; }
        const unsigned old = xb_add(&bar[XB_XSUB(b.x)], 1u);
        const unsigned gen = old / nloc;
        if (old + 1u == (gen + 1u) * nloc) {
            __builtin_amdgcn_fence(__ATOMIC_RELEASE, "agent");
            asm volatile("s_waitcnt vmcnt(0)" ::: "memory");
            const unsigned og = xb_add(&bar[XB_TOP], 1u);
            const unsigned tg = og / nx;
            if (og + 1u == (tg + 1u) * nx) xb_add(&bar[XB_TOPGEN], 1u);
            else XB_SPIN(xb_ld(&bar[XB_TOPGEN]) == tg, bar);
            __builtin_amdgcn_fence(__ATOMIC_ACQUIRE, "agent");
            xb_add(&bar[XB_XGEN(b.x)], 1u);
            asm volatile("s_waitcnt vmcnt(0)" ::: "memory");
        } else {
            XB_SPIN(xb_ld(&bar[XB_XGEN(b.x)]) == gen, bar);
            __builtin_amdgcn_fence(__ATOMIC_ACQUIRE, "agent");
            asm volatile("s_waitcnt vmcnt(0)" ::: "memory");
        }
    }
    __syncthreads();
}

struct Params {
    const float* x; const float* meta; const float* norm_mixer; const float* norm_ffn; const float* norm_final;
    const float* ret_w_in; const float* ret_gn; const float* ret_w_out;
    const float* fox_w_in; const float* fox_b_f; const float* fox_w_out;
    const float* moe_w_rg; const float* moe_b_rg; const float* moe_w_re; const float* moe_b_re;
    const float* moe_w_gate; const float* moe_w_up; const float* moe_w_down;
    float* out; unsigned char* ws; int ph_lo, ph_hi;
};

template <bool NTS = false>
__device__ __forceinline__ void tr_item(const float* W, int ldw, int k0, int n0, bf16* WT, int ldk, int drow0, LAS float* scr, int lane) {
#pragma unroll 4
    for (int i = 0; i < 16; ++i) { const int kk = 4 * i + (lane >> 4), c4 = 4 * (lane & 15);
        const f32x4 v = __builtin_nontemporal_load((const f32x4*)&W[(size_t)(k0 + kk) * ldw + n0 + c4]);
        LAS float* row = scr + kk * 64;
        row[(c4 + 0) ^ kk] = v.x; row[(c4 + 1) ^ kk] = v.y; row[(c4 + 2) ^ kk] = v.z; row[(c4 + 3) ^ kk] = v.w; }
    LDS_WAIT(); asm volatile("" ::: "memory");
    const int c = lane & 7;
#pragma unroll 2
    for (int j = 0; j < 8; ++j) { const int n = (lane >> 3) + 8 * j; float f[8];
#pragma unroll
        for (int e = 0; e < 8; ++e) f[e] = scr[(8 * c + e) * 64 + (n ^ (8 * c + e))];
        v4u o; o.x = pk2(f[0], f[1]); o.y = pk2(f[2], f[3]); o.z = pk2(f[4], f[5]); o.w = pk2(f[6], f[7]);
        if constexpr (NTS) __builtin_nontemporal_store(o, (v4u*)(WT + (size_t)(drow0 + n) * ldk + k0 + 8 * c)); else *(v4u*)(WT + (size_t)(drow0 + n) * ldk + k0 + 8 * c) = o; }
    LDS_WAIT(); asm volatile("" ::: "memory");
}
__device__ __forceinline__ void tr_plain(const float* W, int ldw, int K, int N, bf16* WT, int item, LAS float* scr, int lane) {
    const int nblk = N / 64, kb = item / nblk, nb = item % nblk;
    tr_item(W, ldw, 64 * kb, 64 * nb, WT, K, 64 * nb, scr, lane);
}
__device__ __forceinline__ void tr_moe(const Params& P, int l, int item, LAS float* scr, int lane) {
    bf16* WGU = (bf16*)(P.ws + WS_WGU); bf16* WDN = (bf16*)(P.ws + WS_WDN);
    const int which = item >> 13, r = item & 8191, x = r >> 8, q = r & 255;
    if (which < 2) {
        const float* W = (which == 0 ? P.moe_w_gate : P.moe_w_up) + (size_t)(l * NEXP + x) * DM * FFD;
        const int kb = q >> 3, nb = q & 7, n0 = 64 * nb;
        const int drow0 = (n0 >> 7) * 256 + (n0 & 127) + (which ? 128 : 0);
        tr_item<true>(W, FFD, 64 * kb, n0, WGU + (size_t)x * 1024 * DM, DM, drow0, scr, lane);
    } else {
        const float* W = P.moe_w_down + (size_t)(l * NEXP + x) * FFD * DM;
        const int kb = q >> 5, nb = q & 31;
        tr_item<true>(W, DM, 64 * kb, 64 * nb, WDN + (size_t)x * DM * FFD, FFD, 64 * nb, scr, lane);
    }
}

__device__ __forceinline__ void load_row(const float* row, int lane, f32x4 (&v)[8]) {
#pragma unroll
    for (int j = 0; j < 8; ++j) v[j] = *(const f32x4*)(row + 4 * lane + 256 * j);
}
__device__ __forceinline__ void store_row_f32(float* row, int lane, const f32x4 (&v)[8]) {
#pragma unroll
    for (int j = 0; j < 8; ++j) *(f32x4*)(row + 4 * lane + 256 * j) = v[j];
}
__device__ __forceinline__ void load_row_bf(const bf16* row, int lane, f32x4 (&v)[8]) {
#pragma unroll
    for (int j = 0; j < 8; ++j) { const v2u w = *(const v2u*)(row + 4 * lane + 256 * j); v[j] = (f32x4){bflo(w.x), bfhi(w.x), bflo(w.y), bfhi(w.y)}; }
}
__device__ __forceinline__ void store_row_bf(bf16* row, int lane, const f32x4 (&v)[8]) {
#pragma unroll
    for (int j = 0; j < 8; ++j) { v2u w; w.x = pk2(v[j].x, v[j].y); w.y = pk2(v[j].z, v[j].w); *(v2u*)(row + 4 * lane + 256 * j) = w; }
}
__device__ __forceinline__ void ld8bf(const bf16* p, float (&o)[8]) {
    const v4u w = *(const v4u*)p;
    o[0] = bflo(w.x); o[1] = bfhi(w.x); o[2] = bflo(w.y); o[3] = bfhi(w.y); o[4] = bflo(w.z); o[5] = bfhi(w.z); o[6] = bflo(w.w); o[7] = bfhi(w.w);
}
__device__ __forceinline__ void add_row_bf16(const bf16* row, int lane, f32x4 (&v)[8]) {
#pragma unroll
    for (int j = 0; j < 8; ++j) { const v2u w = __builtin_nontemporal_load((const v2u*)(row + 4 * lane + 256 * j));
        v[j].x += bflo(w.x); v[j].y += bfhi(w.x); v[j].z += bflo(w.y); v[j].w += bfhi(w.y); }
}
__device__ __forceinline__ float rms_gain(f32x4 (&v)[8], const float* gain, int lane) {
    float ss = 0.f;
#pragma unroll
    for (int j = 0; j < 8; ++j) { ss += (v[j].x * v[j].x + v[j].y * v[j].y) + (v[j].z * v[j].z + v[j].w * v[j].w); }
    ss = wave_sum(ss);
    const float rstd = __builtin_amdgcn_rsqf(ss * (1.0f / DM) + RMS_EPS);
#pragma unroll
    for (int j = 0; j < 8; ++j) { const f32x4 g = *(const f32x4*)(gain + 4 * lane + 256 * j); v[j] = v[j] * g; }
    return rstd;
}
__device__ __forceinline__ void store_hn(bf16* row, int lane, const f32x4 (&u)[8], float rstd) {
#pragma unroll
    for (int j = 0; j < 8; ++j) { v2u w; w.x = pk2(u[j].x * rstd, u[j].y * rstd); w.y = pk2(u[j].z * rstd, u[j].w * rstd); *(v2u*)(row + 4 * lane + 256 * j) = w; }
}
__device__ __forceinline__ void zero_hn(bf16* row, int lane) {
#pragma unroll
    for (int j = 0; j < 8; ++j) { v2u w; w.x = 0u; w.y = 0u; *(v2u*)(row + 4 * lane + 256 * j) = w; }
}

__device__ __forceinline__ void phase_prologue(const Params& P, LAS unsigned char* lds, int gw, int NGW, int wave, int lane) {
    asm volatile("" : "+v"(lane)); asm volatile("" : "+s"(gw));
    LAS float* scr = (LAS float*)(lds + wave * 16384);
    bf16* WRI = (bf16*)(P.ws + WS_WRI); bf16* WRO = (bf16*)(P.ws + WS_WRO); bf16* WFI = (bf16*)(P.ws + WS_WFI); bf16* WFO = (bf16*)(P.ws + WS_WFO);
    constexpr int I0 = (DM / 64) * (RNIN / 64), I1 = (RVW / 64) * (DM / 64), I2 = (DM / 64) * (FNQKV / 64), I3 = (DM / 64) * (DM / 64), I4 = 3 * 8192 - HOLE_MOE0;
    constexpr int NIT = I0 + I1 + I2 + I3 + I4;
    _Pragma("nounroll") for (int it = gw; it < NIT; it += NGW) {
        int r = it;
        if (r < I0) { tr_plain(P.ret_w_in, RNIN, DM, RNIN, WRI, r, scr, lane); continue; } r -= I0;
        if (r < I1) { tr_plain(P.ret_w_out, DM, RVW, DM, WRO, r, scr, lane); continue; } r -= I1;
        if (r < I2) { tr_plain(P.fox_w_in, FNIN, DM, FNQKV, WFI, r, scr, lane); continue; } r -= I2;
        if (r < I3) { tr_plain(P.fox_w_out, DM, DM, DM, WFO, r, scr, lane); continue; } r -= I3;
        tr_moe(P, 0, r + HOLE_MOE0, scr, lane);
    }
    { f32x4* WRGT = (f32x4*)(P.ws + WS_WRGT); f32x4* WRET = (f32x4*)(P.ws + WS_WRET); f32x4* WFT = (f32x4*)(P.ws + WS_WFT);
      const int gt = gw * 64 + lane, NGT = NGW * 64;
      _Pragma("nounroll") for (int i = gt; i < 2 * 2048; i += NGT) { const int l = i >> 11, sl = (i >> 6) & 31, ln = i & 63, d = 4 * ln + 256 * (sl >> 2) + (sl & 3);
          const f32x4 w = *(const f32x4*)(P.moe_w_rg + ((size_t)l * DM + d) * 4); h16x4 hv = {(_Float16)w.x, (_Float16)w.y, (_Float16)w.z, (_Float16)w.w};
          ((h16x4*)WRGT)[i] = hv; }
      _Pragma("nounroll") for (int i = gt; i < 2 * 32 * 4 * 64; i += NGT) { const int ln = i & 63, g = (i >> 6) & 3, sl = (i >> 8) & 31, l = i >> 13, d = 4 * ln + 256 * (sl >> 2) + (sl & 3);
          const float* wp = P.moe_w_re + ((size_t)l * DM + d) * 32 + g * 8; const f32x4 w0 = *(const f32x4*)wp, w1 = *(const f32x4*)(wp + 4);
          h16x8 hv = {(_Float16)w0.x, (_Float16)w0.y, (_Float16)w0.z, (_Float16)w0.w, (_Float16)w1.x, (_Float16)w1.y, (_Float16)w1.z, (_Float16)w1.w};
          ((h16x8*)WRET)[i] = hv; }
      _Pragma("nounroll") for (int i = gt; i < 32 * 4 * 64; i += NGT) { const int ln = i & 63, q = (i >> 6) & 3, sl = i >> 8, d = 4 * ln + 256 * (sl >> 2) + (sl & 3);
          WFT[i] = *(const f32x4*)(P.fox_w_in + (size_t)d * FNIN + FNQKV + 4 * q); } }
    bf16* H = (bf16*)(P.ws + WS_H); bf16* HN = (bf16*)(P.ws + WS_HN);
    _Pragma("nounroll") for (int row = gw; row < MROWS; row += NGW) {
        const int b = row / LP, p = row - b * LP;
        bf16* hrow = H + (size_t)row * DM; bf16* nrow = HN + (size_t)row * DM;
        f32x4 v[8];
        if (p < PADR) {
#pragma unroll
            for (int j = 0; j < 8; ++j) v[j] = (f32x4){0.f, 0.f, 0.f, 0.f};
            if (row >= 64 * 256) store_row_bf(hrow, lane, v); zero_hn(nrow, lane); continue; }
        const float* src = (p < PADR + NMETA) ? P.meta + (size_t)(p - PADR) * DM : P.x + ((size_t)b * SEQ + (p - PADR - NMETA)) * DM;
#pragma unroll
        for (int j = 0; j < 8; ++j) v[j] = __builtin_nontemporal_load((const f32x4*)(src + 4 * lane + 256 * j));
        if (row >= 64 * 256) store_row_bf(hrow, lane, v);
        const float rstd = rms_gain(v, P.norm_mixer, lane);
        store_hn(nrow, lane, v, rstd);
    }
}

constexpr int MOE_TAB_OFF = 131072 + 256;
struct MoeTab { LAS int* off; LAS int* cnt; LAS int* tile_e; };
__device__ __forceinline__ MoeTab moe_tab(LAS unsigned char* lds) { MoeTab t; t.off = (LAS int*)(lds + MOE_TAB_OFF); t.cnt = t.off + 64; t.tile_e = t.off + 128; return t; }
__device__ __forceinline__ void moe_tab_build(const Params& P, int l, LAS unsigned char* lds, int wave) {
    const MoeTab T = moe_tab(lds); const unsigned* cnt = (const unsigned*)(P.ws + WS_CTL) + CW_CNT + l * 1024; const int tid = wave * 64 + mk_lane_id();
    __syncthreads();
    if (tid == 0) { int o = 0; for (int e = 0; e < NEXP; ++e) { const int c = (int)cnt[e * 32]; T.off[e] = o; T.cnt[e] = c; o += ((c + 255) >> 8) << 8; } T.off[NEXP] = o; }
    __syncthreads();
    if (tid < 160) { int e = 0; for (int x = 1; x < NEXP; ++x) if (tid * 256 >= T.off[x]) e = x; T.tile_e[tid] = e; }
    __syncthreads();
}
struct EpiRetIn {
    static constexpr bool PERM = true, AFTER_DRAIN = false;
    bf16 *q, *k, *v, *g; const f32x2* rope;
    __device__ __forceinline__ void operator()(const pg8::f32x4 (&acc)[2][2][4][2], const pg8::Unit& u, int wr, int wc, int fr, int fq) const {
        const int row0 = u.pm * 256 + wr * 64 + fr, cc0 = wc * 32 + 8 * fq;
        if (u.pn < 16) {
            bf16* dst = (u.pn < 8 ? q : k) + (size_t)(u.pn & 7) * RDK + cc0;
            const float l2g = u.pn < 8 ? 0.f : __log2f(1.0f - __builtin_amdgcn_exp2f(-5.0f - (float)(u.pn & 7))), sc0 = u.pn < 8 ? 1.0f : 0.0625f;
            float ir[8];
#pragma unroll
            for (int i = 0; i < 8; ++i) ir[i] = __builtin_amdgcn_exp2f((float)(cc0 + i) * (-13.287712379549449f / 128.0f)) * 0.15915494309189535f;
#pragma unroll
            for (int ai = 0; ai < 2; ++ai)
#pragma unroll
                for (int m = 0; m < 4; ++m) {
                    const int row = row0 + ai * 128 + m * 16; const int p = row % LP; const float pf = (float)(p - PADR); const float sc = sc0 * __builtin_amdgcn_exp2f((float)(127 - (p & 127)) * l2g);
                    float cs[8], sn[8];
#pragma unroll
                    for (int i = 0; i < 8; ++i) { const float fr = __builtin_amdgcn_fractf(pf * ir[i]); cs[i] = __builtin_amdgcn_cosf(fr); sn[i] = __builtin_amdgcn_sinf(fr); }
                    float o1[8], o2[8];
#pragma unroll
                    for (int n = 0; n < 2; ++n)
#pragma unroll
                        for (int e = 0; e < 4; ++e) { const float u1 = acc[ai][0][m][n][e], u2 = acc[ai][1][m][n][e]; const int i = 4 * n + e;
                            o1[i] = (u1 * cs[i] - u2 * sn[i]) * sc; o2[i] = (u1 * sn[i] + u2 * cs[i]) * sc; }
                    v4u w1, w2;
                    w1.x = pg8::cvt_pk_bf16(o1[0], o1[1]); w1.y = pg8::cvt_pk_bf16(o1[2], o1[3]); w1.z = pg8::cvt_pk_bf16(o1[4], o1[5]); w1.w = pg8::cvt_pk_bf16(o1[6], o1[7]);
                    w2.x = pg8::cvt_pk_bf16(o2[0], o2[1]); w2.y = pg8::cvt_pk_bf16(o2[2], o2[3]); w2.z = pg8::cvt_pk_bf16(o2[4], o2[5]); w2.w = pg8::cvt_pk_bf16(o2[6], o2[7]);
                    if (u.pn < 8) {
                        const int c1 = cc0 >> 3; bf16* qb = q + (((size_t)(row >> 5) * 8 + u.pn) * 16) * 512 + (row & 31) * 8;
                        *(v4u*)(qb + (c1 >> 1) * 512 + (c1 & 1) * 256) = w1; *(v4u*)(qb + (8 + (c1 >> 1)) * 512 + (c1 & 1) * 256) = w2; }
                    else { bf16* rowp = dst + (size_t)row * DM; *(v4u*)rowp = w1; *(v4u*)(rowp + 128) = w2; }
                }
        } else {
            bf16* dst = (u.pn < 32 ? v + (size_t)(u.pn - 16) * 256 : g + (size_t)(u.pn - 32) * 256) + cc0;
#pragma unroll
            for (int ai = 0; ai < 2; ++ai)
#pragma unroll
                for (int m = 0; m < 4; ++m) { bf16* rowp = dst + (size_t)(row0 + ai * 128 + m * 16) * RVW;
#pragma unroll
                    for (int bj = 0; bj < 2; ++bj) { const pg8::f32x4 v0 = acc[ai][bj][m][0], v1 = acc[ai][bj][m][1]; v4u w;
                        w.x = pg8::cvt_pk_bf16(v0[0], v0[1]); w.y = pg8::cvt_pk_bf16(v0[2], v0[3]); w.z = pg8::cvt_pk_bf16(v1[0], v1[1]); w.w = pg8::cvt_pk_bf16(v1[2], v1[3]);
                        *(v4u*)(rowp + bj * 128) = w; } }
        }
    }
};
template <bool FROMX>
struct EpiResidT {
    static constexpr bool PERM = true, AFTER_DRAIN = false;
    bf16* H; int dry; const float* x; const float* meta;
    __device__ __forceinline__ void operator()(const pg8::f32x4 (&acc)[2][2][4][2], const pg8::Unit& u, int wr, int wc, int fr, int fq) const {
        const int row0 = u.pm * 256 + wr * 64 + fr, col0 = u.pn * 256 + wc * 32 + 8 * fq;
        if (dry && acc[0][0][0][0][0] != 12345.678f) return;
#pragma unroll
        for (int ai = 0; ai < 2; ++ai)
#pragma unroll
            for (int m = 0; m < 4; ++m) { bf16* rowp = H + (size_t)(row0 + ai * 128 + m * 16) * DM + col0;
                if constexpr (FROMX) { const int row = row0 + ai * 128 + m * 16, b = row / LP, pp = row - b * LP;
                    const float* src = pp < PADR + NMETA ? meta + (size_t)(pp < PADR ? 0 : pp - PADR) * DM : x + ((size_t)b * SEQ + (pp - PADR - NMETA)) * DM; const float keep = pp < PADR ? 0.f : 1.f;
#pragma unroll
                    for (int bj = 0; bj < 2; ++bj) { const pg8::f32x4 a0 = *(const pg8::f32x4*)(src + col0 + bj * 128), a1 = *(const pg8::f32x4*)(src + col0 + bj * 128 + 4); const pg8::f32x4 v0 = acc[ai][bj][m][0], v1 = acc[ai][bj][m][1]; v4u w;
                        w.x = pg8::cvt_pk_bf16(a0[0] * keep + v0[0], a0[1] * keep + v0[1]); w.y = pg8::cvt_pk_bf16(a0[2] * keep + v0[2], a0[3] * keep + v0[3]);
                        w.z = pg8::cvt_pk_bf16(a1[0] * keep + v1[0], a1[1] * keep + v1[1]); w.w = pg8::cvt_pk_bf16(a1[2] * keep + v1[2], a1[3] * keep + v1[3]);
                        *(v4u*)(rowp + bj * 128) = w; } }
                else {
#pragma unroll
                for (int bj = 0; bj < 2; ++bj) { v4u* p = (v4u*)(rowp + bj * 128); const v4u h = *p; const pg8::f32x4 v0 = acc[ai][bj][m][0], v1 = acc[ai][bj][m][1]; v4u w;
                    w.x = pg8::cvt_pk_bf16(bflo(h.x) + v0[0], bfhi(h.x) + v0[1]); w.y = pg8::cvt_pk_bf16(bflo(h.y) + v0[2], bfhi(h.y) + v0[3]);
                    w.z = pg8::cvt_pk_bf16(bflo(h.z) + v1[0], bfhi(h.z) + v1[1]); w.w = pg8::cvt_pk_bf16(bflo(h.w) + v1[2], bfhi(h.w) + v1[3]);
                    *p = w; } } }
    }
};
constexpr int LEFT_ROW0 = 64 * 256, LEFT_ROWS = MROWS - LEFT_ROW0;
struct EpiSlab {
    static constexpr bool PERM = false, AFTER_DRAIN = false;
    float* slab; int klen;
    __device__ __forceinline__ void operator()(const pg8::f32x4 (&acc)[2][2][4][2], const pg8::Unit& u, int wr, int wc, int fr, int fq) const {
        const int row0 = (u.pm - 64) * 256 + wr * 64 + fr, col0 = u.pn * 256 + wc * 32 + 4 * fq; float* base = slab + (size_t)(u.ko / klen) * LEFT_ROWS * DM;
#pragma unroll
        for (int ai = 0; ai < 2; ++ai)
#pragma unroll
            for (int m = 0; m < 4; ++m) { float* rowp = base + (size_t)(row0 + ai * 128 + m * 16) * DM + col0;
#pragma unroll
                for (int bj = 0; bj < 2; ++bj)
#pragma unroll
                    for (int n = 0; n < 2; ++n) *(pg8::f32x4*)(rowp + bj * 128 + n * 16) = acc[ai][bj][m][n]; }
    }
};
struct SplitKOrder {
    int pm0, npm, nN, KS, klen, G, c;
    __device__ __forceinline__ bool next(int i, pg8::Unit& u) const {
        const int L = i * G + c; if (L >= npm * nN * KS) return false;
        const int ks = L % KS, t = L / KS; u.pn = t % nN; u.pm = pm0 + t / nN; u.ko = ks * klen; return true;
    }
    __device__ __forceinline__ void a_ready(const pg8::Unit&) const {}
    __device__ __forceinline__ void done(const pg8::Unit&) const {}
};
struct EpiGateUp {
    static constexpr bool PERM = true, AFTER_DRAIN = false;
    bf16* hid; const float* tokwt; MoeTab T;
    __device__ __forceinline__ void operator()(const pg8::f32x4 (&acc)[2][2][4][2], const pg8::Unit& u, int wr, int wc, int fr, int fq) const {
        const int row0 = u.pm * 256 + wr * 64 + fr, col0 = (u.pn & 3) * 128 + wc * 32 + 8 * fq;
#pragma unroll
        for (int ai = 0; ai < 2; ++ai)
#pragma unroll
            for (int m = 0; m < 4; ++m) { const int row = row0 + ai * 128 + m * 16; const int e_ = T.tile_e[u.pm], pos_ = row - T.off[e_]; const float c = pos_ < T.cnt[e_] ? tokwt[e_ * TOKCAP + pos_] : 0.f; float o[8];
#pragma unroll
                for (int n = 0; n < 2; ++n)
#pragma unroll
                    for (int e = 0; e < 4; ++e) { const float a = acc[ai][0][m][n][e], up = acc[ai][1][m][n][e];
                        o[4 * n + e] = a * __builtin_amdgcn_rcpf(1.0f + __expf(-a)) * up * c; }
                v4u w; w.x = pg8::cvt_pk_bf16(o[0], o[1]); w.y = pg8::cvt_pk_bf16(o[2], o[3]); w.z = pg8::cvt_pk_bf16(o[4], o[5]); w.w = pg8::cvt_pk_bf16(o[6], o[7]);
                *(v4u*)(hid + (size_t)row * FFD + col0) = w; }
    }
};
struct EpiDown {
    static constexpr bool PERM = true, AFTER_DRAIN = false;
    bf16* y;
    __device__ __forceinline__ void operator()(const pg8::f32x4 (&acc)[2][2][4][2], const pg8::Unit& u, int wr, int wc, int fr, int fq) const {
        const int row0 = u.pm * 256 + wr * 64 + fr, col0 = (u.pn & 7) * 256 + wc * 32 + 8 * fq;
#pragma unroll
        for (int ai = 0; ai < 2; ++ai)
#pragma unroll
            for (int m = 0; m < 4; ++m) { bf16* rowp = y + (size_t)(row0 + ai * 128 + m * 16) * DM + col0;
#pragma unroll
                for (int bj = 0; bj < 2; ++bj) { const pg8::f32x4 v0 = acc[ai][bj][m][0], v1 = acc[ai][bj][m][1]; v4u w;
                    w.x = pg8::cvt_pk_bf16(v0[0], v0[1]); w.y = pg8::cvt_pk_bf16(v0[2], v0[3]); w.z = pg8::cvt_pk_bf16(v1[0], v1[1]); w.w = pg8::cvt_pk_bf16(v1[2], v1[3]);
                    *(v4u*)(rowp + bj * 128) = w; } }
    }
};
struct GroupSched {
    MoeTab T; const int* tokrow; int TM, NT, G, c;
    __device__ __forceinline__ void init(const MoeTab& t, const int* tr, int nt, int G_, int c_) { T = t; tokrow = tr; TM = t.off[NEXP] >> 8; NT = nt; G = G_; c = c_; }
    __device__ __forceinline__ bool next(int i, pg8::Unit& u) const {
        if (G & 7) { const int L = i * G + c; const int mt = L / NT, nt = L % NT; if (mt >= TM) return false; u.pm = mt; u.pn = T.tile_e[mt] * NT + nt; u.ko = 0; return true; }
        const int cls = c & 7; int j = i * (G >> 3) + (c >> 3);
#pragma unroll
        for (int q = 0; q < 4; ++q) { const int e = cls + 8 * q, m0 = T.off[e] >> 8, n = ((T.off[e + 1] >> 8) - m0) * NT;
            if (j < n) { u.pm = m0 + j / NT; u.pn = e * NT + j % NT; u.ko = 0; return true; }
            j -= n; }
        return false;
    }
    __device__ __forceinline__ int arow(const pg8::Unit& u, int r) const { const int e = T.tile_e[u.pm], pos = u.pm * 256 - T.off[e] + r; return pos < T.cnt[e] ? tokrow[e * TOKCAP + pos] : 0; }
    __device__ __forceinline__ void a_ready(const pg8::Unit&) const {}
    __device__ __forceinline__ void done(const pg8::Unit&) const {}
};

__device__ __forceinline__ void phase_gn_gate(const Params& P, int gw, int NGW, int lane, bool dry = false) {
    asm volatile("" : "+v"(lane)); asm volatile("" : "+s"(gw));
    const bf16* Y = (const bf16*)(P.ws + WS_R2); bf16* G = (bf16*)(P.ws + WS_R2 + 2 * ACT_BYTES);
    constexpr int NIT = MROWS * RH, U = 4;
    _Pragma("nounroll") for (int it0 = gw; it0 < NIT; it0 += NGW * U) {
        v4u yw[U], gw4[U]; size_t off[U];
#pragma unroll
        for (int k = 0; k < U; ++k) { int it = it0 + k * NGW; if (it >= NIT) it = it0; const int row = it >> 3, h = it & 7; off[k] = (size_t)row * RVW + h * RDV + lane * 8;
            yw[k] = __builtin_nontemporal_load((const v4u*)(Y + off[k])); gw4[k] = __builtin_nontemporal_load((const v4u*)(G + off[k])); }
#pragma unroll
        for (int k = 0; k < U; ++k) { const int it = it0 + k * NGW; const int h = it & 7;
            float y[8], g[8];
            y[0] = bflo(yw[k].x); y[1] = bfhi(yw[k].x); y[2] = bflo(yw[k].y); y[3] = bfhi(yw[k].y); y[4] = bflo(yw[k].z); y[5] = bfhi(yw[k].z); y[6] = bflo(yw[k].w); y[7] = bfhi(yw[k].w);
            g[0] = bflo(gw4[k].x); g[1] = bfhi(gw4[k].x); g[2] = bflo(gw4[k].y); g[3] = bfhi(gw4[k].y); g[4] = bflo(gw4[k].z); g[5] = bfhi(gw4[k].z); g[6] = bflo(gw4[k].w); g[7] = bfhi(gw4[k].w);
            float s = 0.f;
#pragma unroll
            for (int i = 0; i < 8; ++i) s += y[i];
            const float mu = wave_sum(s) * (1.0f / RDV); float q = 0.f;
#pragma unroll
            for (int i = 0; i < 8; ++i) { y[i] -= mu; q += y[i] * y[i]; }
            const float rstd = __builtin_amdgcn_rsqf(wave_sum(q) * (1.0f / RDV) + GN_EPS);
            const float* gn = P.ret_gn + h * RDV + lane * 8; float o[8];
#pragma unroll
            for (int i = 0; i < 8; ++i) { const float sg = g[i] * __builtin_amdgcn_rcpf(1.0f + __expf(-g[i])); o[i] = sg * (y[i] * rstd * gn[i]); }
            v4u w; w.x = pk2(o[0], o[1]); w.y = pk2(o[2], o[3]); w.z = pk2(o[4], o[5]); w.w = pk2(o[6], o[7]);
            if (it < NIT && (!dry || rstd < 0.f)) *(v4u*)(G + off[k]) = w; }
    }
}

__device__ __forceinline__ void route_row(const Params& P, int l, int row, const f32x4 (&u)[8], float rstd, int lane, int slot, LAS unsigned char* lds) {
    float lg[4] = {0.f, 0.f, 0.f, 0.f};
    unsigned wo = (unsigned)lane; asm volatile("" : "+v"(wo)); const LAS h16x4* wl = (const LAS h16x4*)(lds + LDS_WRG_OFF) + wo;
#pragma unroll
    for (int j = 0; j < 8; ++j) {
#pragma unroll
        for (int i = 0; i < 4; ++i) { const h16x4 w = wl[(j * 4 + i) * 64]; const float x = u[j][i];
            lg[0] += x * (float)w[0]; lg[1] += x * (float)w[1]; lg[2] += x * (float)w[2]; lg[3] += x * (float)w[3]; } }
    {
      float a2[2], w;
#pragma unroll
      for (int k = 0; k < 2; ++k) { const bool up = (lane & 32) != 0; const float snd = up ? lg[2 * k] : lg[2 * k + 1]; a2[k] = (up ? lg[2 * k + 1] : lg[2 * k]) + __shfl_xor(snd, 32); }
      { const bool up = (lane & 16) != 0; const float snd = up ? a2[0] : a2[1]; w = (up ? a2[1] : a2[0]) + __shfl_xor(snd, 16); }
      w += __shfl_xor(w, 8); w += __shfl_xor(w, 4); w += __shfl_xor(w, 2); w += __shfl_xor(w, 1);
      const int wi = __builtin_bit_cast(int, w);
      lg[0] = __builtin_bit_cast(float, __builtin_amdgcn_readlane(wi, 0)); lg[1] = __builtin_bit_cast(float, __builtin_amdgcn_readlane(wi, 32));
      lg[2] = __builtin_bit_cast(float, __builtin_amdgcn_readlane(wi, 16)); lg[3] = __builtin_bit_cast(float, __builtin_amdgcn_readlane(wi, 48)); }
#pragma unroll
    for (int g = 0; g < 4; ++g) lg[g] = lg[g] * rstd + P.moe_b_rg[l * 4 + g];
    int gs = 0; float gm = lg[0];
#pragma unroll
    for (int g = 1; g < 4; ++g) if (lg[g] > gm) { gm = lg[g]; gs = g; }
    float den = 0.f;
#pragma unroll
    for (int g = 0; g < 4; ++g) den += __expf(lg[g] - gm);
    const float pg = __builtin_amdgcn_rcpf(den);
    float le[8] = {0.f, 0.f, 0.f, 0.f, 0.f, 0.f, 0.f, 0.f};
    unsigned wo2 = (unsigned)lane + (unsigned)gs * 64u; asm volatile("" : "+v"(wo2)); const LAS h16x8* wl2 = (const LAS h16x8*)lds + wo2;
#pragma unroll
    for (int j = 0; j < 8; ++j) {
#pragma unroll
        for (int i = 0; i < 4; ++i) { const h16x8 w = wl2[(j * 4 + i) * 256]; const float x = u[j][i];
#pragma unroll
            for (int e = 0; e < 8; ++e) le[e] += x * (float)w[e]; } }
    {
      float a4[4], a2[2], w;
#pragma unroll
      for (int k = 0; k < 4; ++k) { const bool up = (lane & 32) != 0; const float snd = up ? le[2 * k] : le[2 * k + 1]; a4[k] = (up ? le[2 * k + 1] : le[2 * k]) + __shfl_xor(snd, 32); }
#pragma unroll
      for (int k = 0; k < 2; ++k) { const bool up = (lane & 16) != 0; const float snd = up ? a4[2 * k] : a4[2 * k + 1]; a2[k] = (up ? a4[2 * k + 1] : a4[2 * k]) + __shfl_xor(snd, 16); }
      { const bool up = (lane & 8) != 0; const float snd = up ? a2[0] : a2[1]; w = (up ? a2[1] : a2[0]) + __shfl_xor(snd, 8); }
      w += __shfl_xor(w, 4); w += __shfl_xor(w, 2); w += __shfl_xor(w, 1);
      const int wi = __builtin_bit_cast(int, w);
#pragma unroll
      for (int e = 0; e < 8; ++e) le[e] = __builtin_bit_cast(float, __builtin_amdgcn_readlane(wi, 32 * (e & 1) + 16 * ((e >> 1) & 1) + 8 * ((e >> 2) & 1))); }
#pragma unroll
    for (int e = 0; e < 8; ++e) le[e] = le[e] * rstd + P.moe_b_re[l * 32 + gs * 8 + e];
    int i1 = 0; float m1 = le[0];
#pragma unroll
    for (int e = 1; e < 8; ++e) if (le[e] > m1) { m1 = le[e]; i1 = e; }
    int i2 = -1; float m2 = -3.0e38f;
#pragma unroll
    for (int e = 0; e < 8; ++e) if (e != i1 && le[e] > m2) { m2 = le[e]; i2 = e; }
    const float r = __expf(m2 - m1), w1 = __builtin_amdgcn_rcpf(1.0f + r), w2 = r * w1;
    if (lane == 0) {
        LAS int* rl = (LAS int*)(lds + LDS_ROUTE_OFF); const int e1 = gs * 8 + i1, e2 = gs * 8 + i2;
        const int k = __hip_atomic_fetch_add(rl + 64, 1, __ATOMIC_RELAXED, __HIP_MEMORY_SCOPE_WORKGROUP);
        if (k < ROUTE_MAXENT) {
            const int r1 = __hip_atomic_fetch_add(rl + e1, 1, __ATOMIC_RELAXED, __HIP_MEMORY_SCOPE_WORKGROUP), r2 = __hip_atomic_fetch_add(rl + e2, 1, __ATOMIC_RELAXED, __HIP_MEMORY_SCOPE_WORKGROUP);
            LAS int* en = rl + 80 + 8 * k; en[0] = row; en[1] = e1; en[2] = e2; en[3] = r1; en[4] = r2; ((LAS float*)en)[5] = pg * w1; ((LAS float*)en)[6] = pg * w2;
        } else {
            unsigned* cnt = (unsigned*)(P.ws + WS_CTL) + CW_CNT + slot * 1024; const int p1 = (int)atomicAdd(cnt + e1 * 32, 1u), p2 = (int)atomicAdd(cnt + e2 * 32, 1u);
            int* tok_e = (int*)(P.ws + WS_TOKE); int* tok_p = (int*)(P.ws + WS_TOKP); int* tokrow = (int*)(P.ws + WS_TOKROW); float* tokwt = (float*)(P.ws + WS_TOKWT);
            tok_e[row * 2] = e1; tok_e[row * 2 + 1] = e2; tok_p[row * 2] = p1; tok_p[row * 2 + 1] = p2;
            tokrow[e1 * TOKCAP + p1] = row; tokrow[e2 * TOKCAP + p2] = row; tokwt[e1 * TOKCAP + p1] = pg * w1; tokwt[e2 * TOKCAP + p2] = pg * w2; }
    }
}
__device__ __forceinline__ void route_flush(const Params& P, int slot, LAS unsigned char* lds, int tid) {
    LAS int* rl = (LAS int*)(lds + LDS_ROUTE_OFF);
    __syncthreads();
    if (tid < NEXP) { const int c = rl[tid]; unsigned* cnt = (unsigned*)(P.ws + WS_CTL) + CW_CNT + slot * 1024 + tid * 32; rl[32 + tid] = c ? (int)atomicAdd(cnt, (unsigned)c) : 0; }
    __syncthreads();
    const int nent = rl[64] < ROUTE_MAXENT ? rl[64] : ROUTE_MAXENT;
    if (tid < 2 * nent) { const LAS int* en = rl + 80 + 8 * (tid >> 1); const int j = tid & 1, row = en[0], e = en[1 + j], pos = rl[32 + e] + en[3 + j]; const float w = ((const LAS float*)en)[5 + j];
        int* tok_e = (int*)(P.ws + WS_TOKE); int* tok_p = (int*)(P.ws + WS_TOKP); int* tokrow = (int*)(P.ws + WS_TOKROW); float* tokwt = (float*)(P.ws + WS_TOKWT);
        tok_e[row * 2 + j] = e; tok_p[row * 2 + j] = pos; tokrow[e * TOKCAP + pos] = row; tokwt[e * TOKCAP + pos] = w; }
}
__device__ __forceinline__ void phase_norm_route(const Params& P, int l, int gw, int NGW, int lane, int slot, int nslab, LAS unsigned char* lds, int wave) {
    asm volatile("" : "+v"(lane)); asm volatile("" : "+s"(gw));
    __syncthreads();
    if (wave == 0) { LAS int* rl = (LAS int*)(lds + LDS_ROUTE_OFF); rl[lane] = 0; if (lane == 0) rl[64] = 0; }
    { const v4u* src = (const v4u*)(P.ws + WS_WRET) + (size_t)l * 8192; LAS v4u* dst = (LAS v4u*)lds; const int t0 = wave * 64 + lane;
#pragma unroll
      for (int i = 0; i < 16; ++i) dst[t0 + 512 * i] = src[t0 + 512 * i];
      const v4u* s2 = (const v4u*)(P.ws + WS_WRGT) + (size_t)l * 1024; LAS v4u* d2 = (LAS v4u*)(lds + LDS_WRG_OFF);
#pragma unroll
      for (int i = 0; i < 2; ++i) d2[t0 + 512 * i] = s2[t0 + 512 * i]; }
    __syncthreads();
    const bf16* H = (const bf16*)(P.ws + WS_H); bf16* HN = (bf16*)(P.ws + WS_HN);
    _Pragma("nounroll") for (int row = gw; row < MROWS; row += NGW) {
        const int p = row % LP; bf16* nrow = HN + (size_t)row * DM;
        if (p < PADR) { zero_hn(nrow, lane); continue; }
        f32x4 v[8]; load_row_bf(H + (size_t)row * DM, lane, v);
        if (row >= LEFT_ROW0 && nslab > 0) {
            const float* sl = (const float*)(P.ws + WS_R1 + 2 * ACT_BYTES) + (size_t)(row - LEFT_ROW0) * DM;
            _Pragma("nounroll") for (int k = 0; k < nslab; ++k) { f32x4 t[8]; load_row(sl + (size_t)k * LEFT_ROWS * DM, lane, t);
#pragma unroll
                for (int j = 0; j < 8; ++j) v[j] = v[j] + t[j]; }
            store_row_bf((bf16*)(P.ws + WS_H) + (size_t)row * DM, lane, v); }
        const float rstd = rms_gain(v, P.norm_ffn + (size_t)l * DM, lane);
        store_hn(nrow, lane, v, rstd);
        route_row(P, l, row, v, rstd, lane, slot, lds);
    }
    route_flush(P, slot, lds, wave * 64 + lane);
}
__device__ __forceinline__ void phase_l1_entry(const Params& P, LAS unsigned char* lds, int gw, int NGW, int wave, int lane, bool dry = false) {
    asm volatile("" : "+v"(lane)); asm volatile("" : "+s"(gw));
    LAS float* scr = (LAS float*)(lds + wave * 16384);
    _Pragma("nounroll") for (int it = HOLE_MOE1 + gw; it < 3 * 8192; it += NGW) tr_moe(P, 1, it, scr, lane);
    __syncthreads();
    { const f32x4* src = (const f32x4*)(P.ws + WS_WFT); LAS f32x4* dst = (LAS f32x4*)lds; const int t0 = wave * 64 + lane;
#pragma unroll
      for (int i = 0; i < 16; ++i) dst[t0 + 512 * i] = src[t0 + 512 * i]; }
    __syncthreads();
    bf16* H = (bf16*)(P.ws + WS_H); bf16* HN = (bf16*)(P.ws + WS_HN); const bf16* Y = (const bf16*)(P.ws + WS_R2);
    const int* tok_e = (const int*)(P.ws + WS_TOKE); const int* tok_p = (const int*)(P.ws + WS_TOKP); const MoeTab T = moe_tab(lds); float* LF = (float*)(P.ws + WS_LF);
    _Pragma("nounroll") for (int row = gw; row < MROWS; row += NGW) {
        const int b = row / LP, p = row - b * LP; bf16* nrow = HN + (size_t)row * DM;
        if (p < PADR) { zero_hn(nrow, lane); if (lane < FH) LF[((size_t)b * FH + lane) * LP + p] = 0.f; continue; }
        f32x4 v[8]; bf16* hrow = H + (size_t)row * DM; load_row_bf(hrow, lane, v);
        { const int s0 = T.off[tok_e[row * 2]] + tok_p[row * 2], s1 = T.off[tok_e[row * 2 + 1]] + tok_p[row * 2 + 1];
          add_row_bf16(Y + (size_t)s0 * DM, lane, v); add_row_bf16(Y + (size_t)s1 * DM, lane, v); }
        if (!dry || v[0].x == 1.2345e30f) store_row_bf(hrow, lane, v);
        const float rstd = rms_gain(v, P.norm_mixer + DM, lane);
        if (!dry || rstd < 0.f) store_hn(nrow, lane, v, rstd);
        float f[16];
#pragma unroll
        for (int j = 0; j < 16; ++j) f[j] = 0.f;
        unsigned wfo = (unsigned)lane; asm volatile("" : "+v"(wfo)); const LAS f32x4* wf = (const LAS f32x4*)lds + wfo;
#pragma unroll
        for (int jj = 0; jj < 8; ++jj) {
#pragma unroll
            for (int i = 0; i < 4; ++i) { const LAS f32x4* wp = wf + (jj * 4 + i) * 256; const float x = v[jj][i];
#pragma unroll
                for (int q = 0; q < 4; ++q) { const f32x4 w = wp[64 * q]; f[4 * q] += x * w.x; f[4 * q + 1] += x * w.y; f[4 * q + 2] += x * w.z; f[4 * q + 3] += x * w.w; } } }
        float g8[8], g4[4], g2[2], w1;
#pragma unroll
        for (int k = 0; k < 8; ++k) { const bool up = (lane & 32) != 0; const float snd = up ? f[2 * k] : f[2 * k + 1]; g8[k] = (up ? f[2 * k + 1] : f[2 * k]) + __shfl_xor(snd, 32); }
#pragma unroll
        for (int k = 0; k < 4; ++k) { const bool up = (lane & 16) != 0; const float snd = up ? g8[2 * k] : g8[2 * k + 1]; g4[k] = (up ? g8[2 * k + 1] : g8[2 * k]) + __shfl_xor(snd, 16); }
#pragma unroll
        for (int k = 0; k < 2; ++k) { const bool up = (lane & 8) != 0; const float snd = up ? g4[2 * k] : g4[2 * k + 1]; g2[k] = (up ? g4[2 * k + 1] : g4[2 * k]) + __shfl_xor(snd, 8); }
        { const bool up = (lane & 4) != 0; const float snd = up ? g2[0] : g2[1]; w1 = (up ? g2[1] : g2[0]) + __shfl_xor(snd, 4); }
        w1 += __shfl_xor(w1, 1); w1 += __shfl_xor(w1, 2);
        const int hd = 8 * ((lane >> 2) & 1) + 4 * ((lane >> 3) & 1) + 2 * ((lane >> 4) & 1) + ((lane >> 5) & 1);
        if ((lane & 3) == 0 && (!dry || rstd < 0.f)) { const float xx = w1 * rstd + P.fox_b_f[hd];
            const float ls = fminf(xx, 0.f) - log1pf(__expf(-fabsf(xx)));
            LF[((size_t)b * FH + hd) * LP + p] = ls; }
    }
}
__device__ __forceinline__ void phase_cumsum(const Params& P, int gw, int NGW, int lane) {
    asm volatile("" : "+v"(lane)); asm volatile("" : "+s"(gw));
    const float* LF = (const float*)(P.ws + WS_LF); float* CC = (float*)(P.ws + WS_CC); float* CCS = (float*)(P.ws + WS_CCS);
    _Pragma("nounroll") for (int sq = gw; sq < NB * FH; sq += NGW) {
        const float* src = LF + (size_t)sq * LP + lane * 66; float* dst = CC + (size_t)sq * LP + lane * 66;
        float v[66]; float t = 0.f;
#pragma unroll
        for (int i = 0; i < 66; ++i) { t += src[i]; v[i] = t; }
        float inc = t;
#pragma unroll
        for (int o = 1; o < 64; o <<= 1) { const float n = __shfl_up(inc, o); if (lane >= o) inc += n; }
        const float base = inc - t;
#pragma unroll
        for (int i = 0; i < 66; ++i) { const float c = v[i] + base; dst[i] = c; CCS[(size_t)sq * LP + lane * 66 + i] = c * -11.313708498984761f;   }
    }
}
__device__ __forceinline__ void phase_attn_simple(const Params& P, LAS unsigned char* lds, int wave) {
    const bf16* Q = (const bf16*)(P.ws + WS_R1); const bf16* K = (const bf16*)(P.ws + WS_R1 + ACT_BYTES); const bf16* V = (const bf16*)(P.ws + WS_R1 + 2 * ACT_BYTES);
    bf16* O = (bf16*)(P.ws + WS_R2); const float* CC = (const float*)(P.ws + WS_CC);
    constexpr int LD = 132;
    LAS float* Qs = (LAS float*)lds; LAS float* Ks = Qs + 64 * LD; LAS float* Vs = Ks + 64 * LD; LAS float* Ss = Vs + 64 * LD; LAS float* cks = Ss + 64 * 65;
    const int r = mk_lane_id(), w = wave, tid = w * 64 + r;
    const float scale = 0.08838834764831845f;
    _Pragma("nounroll") for (int unit = blockIdx.x; unit < NB * FH * 66; unit += gridDim.x) {
        const int qb = unit % 66, bh = unit / 66, b = bh / FH, hd = bh % FH;
        if (qb != 1) continue;
        const int q0 = qb * 64; const size_t rbase = (size_t)b * LP;
        __syncthreads();
        { const int rr = tid >> 3, ch = tid & 7;
#pragma unroll
          for (int i = 0; i < 2; ++i) { float f[8]; ld8bf(Q + (rbase + q0 + rr) * DM + hd * FDH + (ch * 2 + i) * 8, f);
#pragma unroll
              for (int j = 0; j < 8; ++j) Qs[rr * LD + (ch * 2 + i) * 8 + j] = f[j]; } }
        const float cq = CC[((size_t)b * FH + hd) * LP + q0 + r]; const int pq = q0 + r;
        float m_run = -1e30f, l_run = 0.f, o[16];
#pragma unroll
        for (int i = 0; i < 16; ++i) o[i] = 0.f;
        _Pragma("nounroll") for (int kt = 1; kt <= qb; ++kt) {
            const int k0 = kt * 64;
            __syncthreads();
            { const int rr = tid >> 3, ch = tid & 7;
#pragma unroll
              for (int i = 0; i < 2; ++i) { float f[8]; ld8bf(K + (rbase + k0 + rr) * DM + hd * FDH + (ch * 2 + i) * 8, f);
#pragma unroll
                  for (int j = 0; j < 8; ++j) Ks[rr * LD + (ch * 2 + i) * 8 + j] = f[j];
                  ld8bf(V + (rbase + k0 + rr) * DM + hd * FDH + (ch * 2 + i) * 8, f);
#pragma unroll
                  for (int j = 0; j < 8; ++j) Vs[rr * LD + (ch * 2 + i) * 8 + j] = f[j]; }
              if (tid < 64) cks[tid] = CC[((size_t)b * FH + hd) * LP + k0 + tid]; }
            __syncthreads();
            { float s[8];
#pragma unroll
              for (int j = 0; j < 8; ++j) s[j] = 0.f;
              for (int d = 0; d < FDH; d += 4) { const f32x4 qv = *(const LAS f32x4*)(Qs + r * LD + d);
#pragma unroll
                  for (int j = 0; j < 8; ++j) { const f32x4 kv = *(const LAS f32x4*)(Ks + (w * 8 + j) * LD + d); s[j] += (qv.x * kv.x + qv.y * kv.y) + (qv.z * kv.z + qv.w * kv.w); } }
#pragma unroll
              for (int j = 0; j < 8; ++j) { const int pk = k0 + w * 8 + j; float sv = s[j] * scale + cq - cks[w * 8 + j];
                  if (pk > pq || pk < PADR) sv = -__builtin_inff();
                  Ss[r * 65 + w * 8 + j] = sv; } }
            __syncthreads();
            { float tm = -__builtin_inff();
              for (int j = 0; j < 64; ++j) tm = fmaxf(tm, Ss[r * 65 + j]);
              const float mn = fmaxf(m_run, tm), alpha = __expf(m_run - mn); m_run = mn; l_run *= alpha;
#pragma unroll
              for (int i = 0; i < 16; ++i) o[i] *= alpha;
              for (int j = 0; j < 64; ++j) { const float pj = __expf(Ss[r * 65 + j] - mn); l_run += pj;
                  const LAS f32x4* vp = (const LAS f32x4*)(Vs + j * LD + w * 16);
#pragma unroll
                  for (int i = 0; i < 4; ++i) { const f32x4 vv = vp[i]; o[4 * i] += pj * vv.x; o[4 * i + 1] += pj * vv.y; o[4 * i + 2] += pj * vv.z; o[4 * i + 3] += pj * vv.w; } } }
        }
        const float inv = l_run > 0.f ? 1.0f / l_run : 0.f;
        v4u w0, w1;
        w0.x = pk2(o[0] * inv, o[1] * inv); w0.y = pk2(o[2] * inv, o[3] * inv); w0.z = pk2(o[4] * inv, o[5] * inv); w0.w = pk2(o[6] * inv, o[7] * inv);
        w1.x = pk2(o[8] * inv, o[9] * inv); w1.y = pk2(o[10] * inv, o[11] * inv); w1.z = pk2(o[12] * inv, o[13] * inv); w1.w = pk2(o[14] * inv, o[15] * inv);
        bf16* op = O + (rbase + q0 + r) * DM + hd * FDH + w * 16;
        *(v4u*)op = w0; *(v4u*)(op + 8) = w1;
    }
}
__device__ __forceinline__ void phase_attn_mfma(const Params& P, char* lds, int wave) {
    constexpr int TOTAL = NB * FH * 8;
    const fa::bf16* Q = (const fa::bf16*)(P.ws + WS_R1); const fa::bf16* K = (const fa::bf16*)(P.ws + WS_R1 + ACT_BYTES); const fa::bf16* V = (const fa::bf16*)(P.ws + WS_R1 + 2 * ACT_BYTES);
    fa::bf16* O = (fa::bf16*)(P.ws + WS_R2); const float* CCS = (const float*)(P.ws + WS_CCS);
    _Pragma("nounroll") for (int L = blockIdx.x; L < TOTAL; L += gridDim.x) {
        const int bh = ((L & 7) * 8) + (L >> 6), x = (L >> 3) & 7;
        const int b = bh / FH, hd = bh % FH; const size_t r0 = (size_t)b * LP;
        _Pragma("nounroll") for (int pass = 0; pass < 2; ++pass) {
            const int qb = pass ? 15 - x : x;
            fa::PlainBlock B; B.P0 = PADR + NMETA + 256 * qb;
            B.Q = Q + (r0 + B.P0) * DM + hd * FDH; B.O = O + (r0 + B.P0) * DM + hd * FDH; B.K = K + r0 * DM + hd * FDH; B.V = V + r0 * DM + hd * FDH;
            B.C = CCS + (size_t)bh * LP;
            fa::attn_dma_block(B, lds, wave);
        }
    }
}
__device__ __forceinline__ void phase_final(const Params& P, LAS unsigned char* lds, int gw, int NGW, int lane) {
    asm volatile("" : "+v"(lane)); asm volatile("" : "+s"(gw));
    const bf16* H = (const bf16*)(P.ws + WS_H); const bf16* Y = (const bf16*)(P.ws + WS_R2); const int* tok_e = (const int*)(P.ws + WS_TOKE); const int* tok_p = (const int*)(P.ws + WS_TOKP); const MoeTab T = moe_tab(lds);
    _Pragma("nounroll") for (int row = gw; row < MROWS; row += NGW) {
        const int b = row / LP, p = row - b * LP; if (p < PADR + NMETA) continue;
        f32x4 v[8]; load_row_bf(H + (size_t)row * DM, lane, v);
        { const int s0 = T.off[tok_e[row * 2]] + tok_p[row * 2], s1 = T.off[tok_e[row * 2 + 1]] + tok_p[row * 2 + 1];
          add_row_bf16(Y + (size_t)s0 * DM, lane, v); add_row_bf16(Y + (size_t)s1 * DM, lane, v); }
        const float rstd = rms_gain(v, P.norm_final, lane);
        float* orow = P.out + ((size_t)b * SEQ + (p - PADR - NMETA)) * DM;
#pragma unroll
        for (int j = 0; j < 8; ++j) __builtin_nontemporal_store(v[j] * rstd, (f32x4*)(orow + 4 * lane + 256 * j));
    }
}

constexpr int RING_BYTES = 131072, MISC_OFF = RING_BYTES + 64, LDS_BYTES = 155648;
constexpr int NPHASE = 19;
__global__ void __launch_bounds__(NTHREADS, 2) mk_fwd(Params P) {
    extern __shared__ __attribute__((aligned(16))) unsigned char lds_raw[];
    LAS unsigned char* lds = (LAS unsigned char*)lds_raw;
    volatile LAS unsigned* MISC = (volatile LAS unsigned*)(lds + MISC_OFF);
    const int wave = __builtin_amdgcn_readfirstlane((int)threadIdx.x >> 6);
    const int G = gridDim.x, gw = blockIdx.x * NWAVES + wave, NGW = G * NWAVES;
    { const int t0 = wave * 64 + mk_lane_id(); if (t0 < 16) MISC[t0] = 0u; }
    __syncthreads();
    unsigned* ctl = (unsigned*)(P.ws + WS_CTL);
    XcdBarrier bar; bar.bar = ctl + CW_BAR; bar.x = 0; bar.st = MISC + 8; bar.wave = wave;
    const bool one = (P.ph_hi - P.ph_lo) > 1;
    if (one) bar = xcd_barrier_post(ctl + CW_BAR, MISC + 8, wave);
    const int lo = P.ph_lo, hi = P.ph_hi;
#define IN(k) (lo <= (k) && (k) < hi)
#define SEAM(k) do { if (IN(k) && IN((k) + 1)) xcd_barrier(bar); } while (0)
#ifndef PROBE_ATT_REPS
#define PROBE_ATT_REPS 1
#endif
#ifndef PROBE_RET_DRY
#define PROBE_RET_DRY 0
#endif
#ifndef PROBE_DRY_OUT
#define PROBE_DRY_OUT 0
#endif
#ifndef PROBE_DUP
#define PROBE_DUP 0u
#endif
#define DUP(k, ...) do { if ((PROBE_DUP >> (k)) & 1u) { xcd_barrier(bar); __VA_ARGS__; } } while (0)
    bf16* HN = (bf16*)(P.ws + WS_HN); bf16* H = (bf16*)(P.ws + WS_H);
    bf16* R1 = (bf16*)(P.ws + WS_R1); bf16* R2 = (bf16*)(P.ws + WS_R2);

    if (IN(0)) { phase_prologue(P, lds, gw, NGW, wave, mk_lane_id());  DUP(0, { phase_prologue(P, lds, gw, NGW, wave, mk_lane_id()); }); } SEAM(0);
    if (IN(1)) { pg8::Gemm g{HN, (const bf16*)(P.ws + WS_WRI), MROWS, RNIN, DM, 0}; pg8::StaticOrder S; S.init(MROWS, RNIN, G, (int)blockIdx.x);
        EpiRetIn E{R1, R1 + (size_t)MROWS * DM, R2, R2 + (size_t)MROWS * RVW, (const f32x2*)(P.ws + WS_ROPE)};
        pg8::gemm_phase<EpiRetIn, pg8::StaticOrder, true, true>(lds, g, S, E, wave);
        { constexpr int EX = ((MROWS / 256) * (RNIN / 256)) % 256; if (G == 256 && (int)blockIdx.x >= EX) { __syncthreads(); LAS float* scr = (LAS float*)(lds + wave * 16384); const int lane_ = mk_lane_id();
            _Pragma("nounroll") for (int it = ((int)blockIdx.x - EX) * 8 + wave; it < HOLE_MOE0; it += (256 - EX) * 8) tr_moe(P, 0, it, scr, lane_); }
          else if (G != 256) { __syncthreads(); LAS float* scr = (LAS float*)(lds + wave * 16384); const int lane_ = mk_lane_id(); _Pragma("nounroll") for (int it = gw; it < HOLE_MOE0; it += NGW) tr_moe(P, 0, it, scr, lane_); } }
        DUP(1, { pg8::Gemm g{HN, (const bf16*)(P.ws + WS_WRI), MROWS, RNIN, DM, 0}; pg8::StaticOrder S; S.init(MROWS, RNIN, G, (int)blockIdx.x);
        EpiRetIn E{R1, R1 + (size_t)MROWS * DM, R2, R2 + (size_t)MROWS * RVW, (const f32x2*)(P.ws + WS_ROPE)};
        pg8::gemm_phase<EpiRetIn, pg8::StaticOrder, true, true>(lds, g, S, E, wave); }); } SEAM(1);
    if (IN(2)) { if (PROBE_RET_DRY) { rt::phase_retention((const bf16*)R1, (const bf16*)(R1 + (size_t)MROWS * DM), R2, lds, NB, LP, wave, true); __syncthreads(); } rt::phase_retention((const bf16*)R1, (const bf16*)(R1 + (size_t)MROWS * DM), R2, lds, NB, LP, wave); } SEAM(2);
    if (IN(3)) { if ((PROBE_DUP >> 3) & 1u) { phase_gn_gate(P, gw, NGW, mk_lane_id(), true); xcd_barrier(bar); } phase_gn_gate(P, gw, NGW, mk_lane_id()); } SEAM(3);
    if (IN(4)) { { pg8::Gemm g{R2 + (size_t)MROWS * RVW, (const bf16*)(P.ws + WS_WRO), 64 * 256, DM, RVW, 0}; pg8::StaticOrder S; S.init(64 * 256, DM, G, (int)blockIdx.x);
          EpiResidT<true> E{H, 0, P.x, P.meta}; pg8::gemm_phase<EpiResidT<true>, pg8::StaticOrder, true, true>(lds, g, S, E, wave); }
        { pg8::Gemm g{R2 + (size_t)MROWS * RVW, (const bf16*)(P.ws + WS_WRO), MROWS, DM, 256, RVW}; SplitKOrder S{64, 2, 8, 16, 256, G, (int)blockIdx.x};
          EpiSlab E{(float*)(P.ws + WS_R1 + 2 * ACT_BYTES), 256}; pg8::gemm_phase<EpiSlab, SplitKOrder, true, true>(lds, g, S, E, wave); } } SEAM(4);
    if (IN(5)) { if ((PROBE_DUP >> 5) & 1u) { phase_norm_route(P, 0, gw, NGW, mk_lane_id(), 2, 0, lds, wave); xcd_barrier(bar); } phase_norm_route(P, 0, gw, NGW, mk_lane_id(), 0, 16, lds, wave); } SEAM(5);
    if (IN(7)) { moe_tab_build(P, 0, lds, wave); pg8::Gemm g{HN, (const bf16*)(P.ws + WS_WGU), MROWS, NEXP * 1024, DM, 0}; GroupSched S; S.init(moe_tab(lds), (const int*)(P.ws + WS_TOKROW), 4, G, (int)blockIdx.x);
        EpiGateUp E{R2 + (size_t)MAXSLOT * DM, (const float*)(P.ws + WS_TOKWT), moe_tab(lds)}; pg8::gemm_phase<EpiGateUp, GroupSched, true, true, true>(lds, g, S, E, wave); } SEAM(7);
    if (IN(8)) { moe_tab_build(P, 0, lds, wave); pg8::Gemm g{R2 + (size_t)MAXSLOT * DM, (const bf16*)(P.ws + WS_WDN), MAXSLOT, NEXP * DM, FFD, 0}; GroupSched S; S.init(moe_tab(lds), nullptr, 8, G, (int)blockIdx.x);
        EpiDown E{R2}; pg8::gemm_phase<EpiDown, GroupSched, true, true>(lds, g, S, E, wave); } SEAM(8);
    if (IN(9)) { if ((PROBE_DUP >> 9) & 1u) { moe_tab_build(P, 0, lds, wave); phase_l1_entry(P, lds, gw, NGW, wave, mk_lane_id(), true); xcd_barrier(bar); } moe_tab_build(P, 0, lds, wave); phase_l1_entry(P, lds, gw, NGW, wave, mk_lane_id()); } SEAM(9);
    if (IN(11)) { { const int sq = G - 1 - (int)blockIdx.x;
          if (wave == 0) phase_cumsum(P, sq < NB * FH ? sq : NB * FH, G >= NB * FH ? NB * FH : G, mk_lane_id()); }
        pg8::Gemm g{HN, (const bf16*)(P.ws + WS_WFI), MROWS, FNQKV, DM, 0}; pg8::StaticOrder S; S.init(MROWS, FNQKV, G, (int)blockIdx.x);
        pg8::EpiBf16<0> E{R1, DM, nullptr, DM, (size_t)MROWS * DM, 1.0f}; pg8::gemm_phase<pg8::EpiBf16<0>, pg8::StaticOrder, true, true>(lds, g, S, E, wave);
        { constexpr int EX = ((MROWS / 256) * (FNQKV / 256)) % 256; if (G == 256 && (int)blockIdx.x >= EX) { __syncthreads(); LAS float* scr = (LAS float*)(lds + wave * 16384); const int lane_ = mk_lane_id();
            _Pragma("nounroll") for (int it = ((int)blockIdx.x - EX) * 8 + wave; it < HOLE_MOE1; it += (256 - EX) * 8) tr_moe(P, 1, it, scr, lane_); }
          else if (G != 256) { __syncthreads(); LAS float* scr = (LAS float*)(lds + wave * 16384); const int lane_ = mk_lane_id(); _Pragma("nounroll") for (int it = gw; it < HOLE_MOE1; it += NGW) tr_moe(P, 1, it, scr, lane_); } }
        DUP(11, { pg8::Gemm g{HN, (const bf16*)(P.ws + WS_WFI), MROWS, FNQKV, DM, 0}; pg8::StaticOrder S; S.init(MROWS, FNQKV, G, (int)blockIdx.x);
        pg8::EpiBf16<0> E{R1, DM, nullptr, DM, (size_t)MROWS * DM, 1.0f}; pg8::gemm_phase<pg8::EpiBf16<0>, pg8::StaticOrder, true, true>(lds, g, S, E, wave); }); } SEAM(11);
    if (IN(12)) { _Pragma("nounroll") for (int rep_ = 0; rep_ < PROBE_ATT_REPS; ++rep_) { phase_attn_mfma(P, (char*)lds_raw, wave); __syncthreads(); } phase_attn_simple(P, lds, wave); if ((PROBE_DUP >> 20) & 1u) { __syncthreads(); phase_attn_simple(P, lds, wave); } } SEAM(12);
    if (IN(13)) { { pg8::Gemm g{R2, (const bf16*)(P.ws + WS_WFO), 64 * 256, DM, DM, 0}; pg8::StaticOrder S; S.init(64 * 256, DM, G, (int)blockIdx.x);
          EpiResidT<false> E{H, 0, nullptr, nullptr}; pg8::gemm_phase<EpiResidT<false>, pg8::StaticOrder, true, true>(lds, g, S, E, wave); }
        { pg8::Gemm g{R2, (const bf16*)(P.ws + WS_WFO), MROWS, DM, 256, DM}; SplitKOrder S{64, 2, 8, 8, 256, G, (int)blockIdx.x};
          EpiSlab E{(float*)(P.ws + WS_R1 + 2 * ACT_BYTES), 256}; pg8::gemm_phase<EpiSlab, SplitKOrder, true, true>(lds, g, S, E, wave); } } SEAM(13);
    if (IN(14)) { if ((PROBE_DUP >> 14) & 1u) { phase_norm_route(P, 1, gw, NGW, mk_lane_id(), 3, 0, lds, wave); xcd_barrier(bar); } phase_norm_route(P, 1, gw, NGW, mk_lane_id(), 1, 8, lds, wave); } SEAM(14);
    if (IN(16)) { moe_tab_build(P, 1, lds, wave); pg8::Gemm g{HN, (const bf16*)(P.ws + WS_WGU), MROWS, NEXP * 1024, DM, 0}; GroupSched S; S.init(moe_tab(lds), (const int*)(P.ws + WS_TOKROW), 4, G, (int)blockIdx.x);
        EpiGateUp E{R2 + (size_t)MAXSLOT * DM, (const float*)(P.ws + WS_TOKWT), moe_tab(lds)}; pg8::gemm_phase<EpiGateUp, GroupSched, true, true, true>(lds, g, S, E, wave); } SEAM(16);
    if (IN(17)) { moe_tab_build(P, 1, lds, wave); pg8::Gemm g{R2 + (size_t)MAXSLOT * DM, (const bf16*)(P.ws + WS_WDN), MAXSLOT, NEXP * DM, FFD, 0}; GroupSched S; S.init(moe_tab(lds), nullptr, 8, G, (int)blockIdx.x);
        EpiDown E{R2}; pg8::gemm_phase<EpiDown, GroupSched, true, true>(lds, g, S, E, wave); } SEAM(17);
    if (IN(18)) { moe_tab_build(P, 1, lds, wave); phase_final(P, lds, gw, NGW, mk_lane_id()); }
#undef IN
#undef SEAM
}

extern "C" void kernel_launch(void* const* d_in, const int* in_sizes, int n_in, void* d_out, int out_size, void* d_ws, size_t ws_size, hipStream_t stream) {
    static int grid = 0;
    if (grid == 0) {
        if (n_in != 18 || ws_size < WS_END) { fprintf(stderr, "kernel_launch: expected 18 inputs and >= %zu bytes of workspace; got %d, %zu\n", (size_t)WS_END, n_in, ws_size); grid = -1; return; }
        int dev = 0, cus = 0, per_cu = 0;
        if (hipGetDevice(&dev) != hipSuccess || hipDeviceGetAttribute(&cus, hipDeviceAttributeMultiprocessorCount, dev) != hipSuccess) { grid = -1; return; }
        if (hipFuncSetAttribute((const void*)mk_fwd, hipFuncAttributeMaxDynamicSharedMemorySize, LDS_BYTES) != hipSuccess) { fprintf(stderr, "kernel_launch: hipFuncSetAttribute failed\n"); grid = -1; return; }
        if (hipOccupancyMaxActiveBlocksPerMultiprocessor(&per_cu, (const void*)mk_fwd, NTHREADS, LDS_BYTES) != hipSuccess || per_cu < 1)
            fprintf(stderr, "kernel_launch: note: occupancy query reports %d workgroups per CU\n", per_cu);
        (void)hipGetLastError();
        grid = cus;
    }
    if (grid < 0) return;
    (void)hipMemsetAsync((char*)d_ws + WS_CTL, 0, CTL_ZERO_BYTES, stream);
    Params p{};
    p.x = (const float*)d_in[0]; p.meta = (const float*)d_in[1]; p.norm_mixer = (const float*)d_in[2]; p.norm_ffn = (const float*)d_in[3]; p.norm_final = (const float*)d_in[4];
    p.ret_w_in = (const float*)d_in[5]; p.ret_gn = (const float*)d_in[6]; p.ret_w_out = (const float*)d_in[7];
    p.fox_w_in = (const float*)d_in[8]; p.fox_b_f = (const float*)d_in[9]; p.fox_w_out = (const float*)d_in[10];
    p.moe_w_rg = (const float*)d_in[11]; p.moe_b_rg = (const float*)d_in[12]; p.moe_w_re = (const float*)d_in[13]; p.moe_b_re = (const float*)d_in[14];
    p.moe_w_gate = (const float*)d_in[15]; p.moe_w_up = (const float*)d_in[16]; p.moe_w_down = (const float*)d_in[17];
    p.out = (float*)d_out; p.ws = (unsigned char*)d_ws;
#if MK_ONE_LAUNCH
    p.ph_lo = 0; p.ph_hi = NPHASE;
    hipLaunchKernelGGL(mk_fwd, dim3(grid), dim3(NTHREADS), LDS_BYTES, stream, p);
#else
    for (int k = 0; k < NPHASE; ++k) { p.ph_lo = k; p.ph_hi = k + 1; hipLaunchKernelGGL(mk_fwd, dim3(grid), dim3(NTHREADS), LDS_BYTES, stream, p); }
#endif
}
```

```cpp
#include <hip/hip_runtime.h>
#include <cstdio>
#include <cstdint>
__device__ __forceinline__ int mk_lane_id() { int l; asm volatile("v_mbcnt_lo_u32_b32 %0, -1, 0\n\tv_mbcnt_hi_u32_b32 %0, -1, %0" : "=v"(l)); return l; }
namespace pg8 {
#define PG8_LAS __attribute__((address_space(3)))
typedef unsigned short bf16_t;
typedef short bf16x8 __attribute__((ext_vector_type(8)));
typedef float f32x4 __attribute__((ext_vector_type(4)));
typedef unsigned u32x4 __attribute__((ext_vector_type(4)));
constexpr int BM = 256, BK = 64, HALF = 128, HTB = HALF * BK * 2  , STAGE_BYTES = 8 * HTB, NXCD = 8, WGM = 8;

__host__ __device__ __forceinline__ int lds_byte(int r, int c) { const int st = (r >> 4) * 2 + (c >> 5), rr = r & 15, cc = c & 31, ob = rr * 64 + cc * 2; return st * 1024 + (ob ^ (((ob >> 9) & 1) << 5)); }
__host__ __device__ __forceinline__ void stage_rc(int b, int& R, int& C) { const int st = b / 1024, sb = b % 1024, swz = sb ^ (((sb >> 9) & 1) << 5); R = (st >> 1) * 16 + swz / 64; C = (st & 1) * 32 + (swz % 64) / 2; }
__host__ __device__ __forceinline__ int perm32(int rho) { const int n = rho >> 4, i = rho & 15; return 8 * (i >> 2) + 4 * n + (i & 3); }

struct Unit { int pm, pn, ko; };
struct Gemm { const bf16_t* A; const bf16_t* Bt; int M, N, K, ld; };

struct StaticOrder {
    int nM, nN, nwg, G, c;
    __host__ __device__ void init(int M, int N, int G_, int c_) { nM = M / BM; nN = N / BM; nwg = nM * nN; G = G_; c = c_; }
    __host__ __device__ bool next(int i, Unit& u) const {
        const long L = (long)i * G + c; if (L >= nwg) return false;
        int wgid = (int)L; { const int q = nwg / NXCD, r = nwg % NXCD, xcd = wgid % NXCD, off = wgid / NXCD; wgid = (xcd < r ? xcd * (q + 1) : r * (q + 1) + (xcd - r) * q) + off; }
        const int nig = WGM * nN, gid = wgid / nig, fm = gid * WGM, gsz = (nM - fm) < WGM ? (nM - fm) : WGM;
        u.pm = fm + ((wgid % nig) % gsz); u.pn = (wgid % nig) / gsz; u.ko = 0; return true;
    }
    __device__ __forceinline__ void a_ready(const Unit&) const {}
    __device__ __forceinline__ void done(const Unit&) const {}
};
__device__ __forceinline__ unsigned cvt_pk_bf16(float lo, float hi) { unsigned r; asm volatile("v_cvt_pk_bf16_f32 %0, %1, %2" : "=v"(r) : "v"(lo), "v"(hi)); return r; }
template <int ACT  > struct EpiBf16 {
    static constexpr bool PERM = true, AFTER_DRAIN = false; static_assert(ACT == 0 || ACT == 1, "EpiBf16: ACT is 0 (none) or 1 (gelu_pk)");
    bf16_t* O; int ldc; const float* bias; int split_cols; size_t split_stride; float scale0;
    __device__ __forceinline__ void operator()(const f32x4 (&acc)[2][2][4][2], const Unit& u, int wr, int wc, int fr, int fq) const {
        const int row0 = u.pm * BM + wr * 64 + fr; int colt = u.pn * BM; bf16_t* base = O;
        float sc = 1.f; if (split_cols) { const int t = colt / split_cols; base += (size_t)t * split_stride; colt -= t * split_cols; if (t == 0) sc = scale0; }
        const int col0 = colt + wc * 32 + 8 * fq, bcol0 = u.pn * BM + wc * 32 + 8 * fq;
        f32x4 bv[2][2];
#pragma unroll
        for (int bj = 0; bj < 2; ++bj)
#pragma unroll
            for (int n = 0; n < 2; ++n) bv[bj][n] = bias ? *(const f32x4*)(bias + bcol0 + bj * HALF + 4 * n) : (f32x4){0.f, 0.f, 0.f, 0.f};
#pragma unroll
        for (int ai = 0; ai < 2; ++ai)
#pragma unroll
            for (int m = 0; m < 4; ++m) { bf16_t* rowp = base + (size_t)(row0 + ai * HALF + m * 16) * ldc + col0;
#pragma unroll
                for (int bj = 0; bj < 2; ++bj) { f32x4 v0 = acc[ai][bj][m][0] + bv[bj][0], v1 = acc[ai][bj][m][1] + bv[bj][1];
                    v0 = v0 * sc; v1 = v1 * sc; u32x4 w; w.x = cvt_pk_bf16(v0[0], v0[1]); w.y = cvt_pk_bf16(v0[2], v0[3]); w.z = cvt_pk_bf16(v1[0], v1[1]); w.w = cvt_pk_bf16(v1[2], v1[3]);
                    *(u32x4*)(rowp + bj * HALF) = w; } }
    }
};
template <class Epi, class Sched, bool ALIGN_EPI = false, bool SP2 = false, bool GATHER = false>
__device__ __forceinline__ void gemm_phase(PG8_LAS unsigned char* lds, const Gemm g, const Sched& S, const Epi& E, int wave_sgpr) {
    int tid_ = wave_sgpr * 64 + mk_lane_id(); asm volatile("" : "+v"(tid_));
    const int tid = tid_, wid = __builtin_amdgcn_readfirstlane(tid >> 6), lane = tid & 63, wr = wid >> 2, wc = wid & 3, fr = lane & 15, fq = lane >> 4;
    const int K = g.ld ? g.ld : g.K, nt = g.K / BK;
    unsigned voffA[2], voffB[2];
#pragma unroll
    for (int i = 0; i < 2; ++i) { int R, C; stage_rc(tid * 16 + i * 8192, R, C); const int Rb = Epi::PERM ? ((R & ~31) + perm32(R & 31)) : R;
        voffA[i] = (unsigned)(R * K + C) * 2u; voffB[i] = (unsigned)(Rb * K + C) * 2u; }
    static_assert(!GATHER || SP2, "the gather staging is written for the SP2 loop");
    const size_t kstep = (size_t)(BK * 2);
    const size_t hstep = (size_t)HALF * K * 2;
    const size_t tstep = 2 * hstep;
    const unsigned ldsw = (unsigned)wid * 1024u;
    const int aoff = lds_byte(wr * 64 + fr, fq * 8), boff = lds_byte(wc * 32 + fr, fq * 8);
#define PG8_SA(b, h) (((b) * 2 + (h)) * HTB)
#define PG8_SB(b, h) ((4 + (b) * 2 + (h)) * HTB)
#define PG8_STAGE(bufoff, gbase, voff) do { _Pragma("unroll") for (int _i = 0; _i < 2; ++_i) \
        __builtin_amdgcn_global_load_lds((const unsigned*)((const char*)(gbase) + (voff)[_i]), (PG8_LAS unsigned*)(lds + (bufoff) + ldsw + _i * 8192), 16, 0, 0); } while (0)
#define PG8_GFILL(u_, v_) do { _Pragma("unroll") for (int h_ = 0; h_ < 2; ++h_) _Pragma("unroll") for (int i_ = 0; i_ < 2; ++i_) { int R_, C_; stage_rc(tid * 16 + i_ * 8192, R_, C_); \
        v_[h_][i_] = ((unsigned)S.arow(u_, h_ * HALF + R_) * (unsigned)K + (unsigned)C_) * 2u; } } while (0)
#define PG8_STAGE_A(bufoff, gbase, half, nx) do { if constexpr (GATHER) { const unsigned s_[2] = {(nx) ? nvA[half][0] : cvA[half][0], (nx) ? nvA[half][1] : cvA[half][1]}; PG8_STAGE(bufoff, gbase, s_); } \
        else { PG8_STAGE(bufoff, (gbase) + (half) * hstep, voffA); } } while (0)
#define PG8_LDA(dst, b, h) do { _Pragma("unroll") for (int m = 0; m < 4; ++m) _Pragma("unroll") for (int k = 0; k < 2; ++k) dst[m][k] = *(const PG8_LAS bf16x8*)(lds + PG8_SA(b, h) + aoff + m * 2048 + k * 1024); } while (0)
#define PG8_LDB(dst, b, h) do { _Pragma("unroll") for (int n = 0; n < 2; ++n) _Pragma("unroll") for (int k = 0; k < 2; ++k) dst[n][k] = *(const PG8_LAS bf16x8*)(lds + PG8_SB(b, h) + boff + n * 2048 + k * 1024); } while (0)
#define PG8_MMA(ai, bj, At, Bt) do { __builtin_amdgcn_s_setprio(1); _Pragma("unroll") for (int m = 0; m < 4; ++m) _Pragma("unroll") for (int n = 0; n < 2; ++n) _Pragma("unroll") for (int k = 0; k < 2; ++k) \
        acc[ai][bj][m][n] = __builtin_amdgcn_mfma_f32_16x16x32_bf16(Bt[n][k], At[m][k], acc[ai][bj][m][n], 0, 0, 0); __builtin_amdgcn_s_setprio(0); } while (0)
#define PG8_WAIT_V(n) asm volatile("s_waitcnt vmcnt(" #n ")" ::: "memory")
#define PG8_WAIT_L(n) asm volatile("s_waitcnt lgkmcnt(" #n ")" ::: "memory")
#define PG8_BAR __builtin_amdgcn_s_barrier()
#define PG8_SCHED __builtin_amdgcn_sched_barrier(0)
    Unit cur, nxt; int ui = 0;
    if (!S.next(0, cur)) return;
    f32x4 acc[2][2][4][2];
#pragma unroll
    for (int a = 0; a < 2; ++a)
#pragma unroll
        for (int b = 0; b < 2; ++b)
#pragma unroll
            for (int m = 0; m < 4; ++m)
#pragma unroll
                for (int n = 0; n < 2; ++n) acc[a][b][m][n] = (f32x4){0.f, 0.f, 0.f, 0.f};
    bf16x8 At[4][2], B0[2][2], B1[2][2];
    unsigned cvA[2][2], nvA[2][2];
    if constexpr (GATHER) { PG8_GFILL(cur, cvA); PG8_GFILL(cur, nvA); }
    const char* cA = GATHER ? (const char*)g.A : (const char*)g.A + (size_t)cur.pm * tstep + (size_t)cur.ko * 2; const char* cB = (const char*)g.Bt + (size_t)cur.pn * tstep + (size_t)cur.ko * 2;
    S.a_ready(cur);
    if constexpr (SP2) {
        PG8_STAGE(PG8_SB(0, 0), cB, voffB); PG8_STAGE(PG8_SB(0, 1), cB + hstep, voffB); PG8_STAGE_A(PG8_SA(0, 0), cA, 0, false); PG8_STAGE_A(PG8_SA(0, 1), cA, 1, false);
        if (wr == 1) PG8_BAR;
        PG8_WAIT_V(2); PG8_BAR;
        PG8_STAGE(PG8_SB(1, 0), cB + kstep, voffB); PG8_STAGE_A(PG8_SA(1, 0), cA + kstep, 0, false); PG8_STAGE(PG8_SB(1, 1), cB + hstep + kstep, voffB);
        PG8_WAIT_V(6); PG8_BAR;
    } else {
        PG8_STAGE(PG8_SB(0, 0), cB, voffB); PG8_STAGE(PG8_SA(0, 0), cA, voffA); PG8_STAGE(PG8_SB(0, 1), cB + hstep, voffB); PG8_STAGE(PG8_SA(0, 1), cA + hstep, voffA);
        if (wr == 1) PG8_BAR;
        PG8_WAIT_V(4); PG8_BAR;
        PG8_STAGE(PG8_SB(1, 0), cB + kstep, voffB); PG8_STAGE(PG8_SA(1, 0), cA + kstep, voffA); PG8_STAGE(PG8_SB(1, 1), cB + hstep + kstep, voffB);
        PG8_WAIT_V(6); PG8_BAR;
    }
    for (;;) {
        const bool has_next = S.next(ui + 1, nxt);
        if constexpr (GATHER) { if (has_next) PG8_GFILL(nxt, nvA); }
        const char* nA = GATHER ? cA : has_next ? (const char*)g.A + (size_t)nxt.pm * tstep + (size_t)nxt.ko * 2 : cA; const char* nB = has_next ? (const char*)g.Bt + (size_t)nxt.pn * tstep + (size_t)nxt.ko * 2 : cB;
        for (int t = 0; t < nt; t += 2) {
            const bool last = (t == nt - 2);
            const char* a1 = cA + (size_t)(t + 1) * kstep;
            const char* a2 = last ? nA : cA + (size_t)(t + 2) * kstep; const char* b2 = last ? nB : cB + (size_t)(t + 2) * kstep;
            const char* a3 = a2 + kstep; const char* b3 = b2 + kstep;
            if (last && has_next) S.a_ready(nxt);
            if constexpr (SP2) {
            PG8_LDB(B0, 0, 0); PG8_LDB(B1, 0, 1); PG8_SCHED; PG8_LDA(At, 0, 0); PG8_STAGE_A(PG8_SA(1, 1), a1, 1, false);
            PG8_WAIT_V(8); PG8_WAIT_L(0); PG8_BAR; PG8_MMA(0, 0, At, B0); PG8_MMA(0, 1, At, B1); PG8_BAR; PG8_SCHED;
            PG8_LDA(At, 0, 1); PG8_STAGE(PG8_SB(0, 0), b2, voffB); PG8_STAGE(PG8_SB(0, 1), b2 + hstep, voffB); PG8_STAGE_A(PG8_SA(0, 0), a2, 0, last);
            PG8_WAIT_V(8); PG8_WAIT_L(0); PG8_BAR; PG8_MMA(1, 0, At, B0); PG8_MMA(1, 1, At, B1); PG8_BAR; PG8_SCHED;
            PG8_LDB(B0, 1, 0); PG8_LDB(B1, 1, 1); PG8_SCHED; PG8_LDA(At, 1, 0); PG8_STAGE_A(PG8_SA(0, 1), a2, 1, last);
            PG8_WAIT_V(8); PG8_WAIT_L(0); PG8_BAR; PG8_MMA(0, 0, At, B0); PG8_MMA(0, 1, At, B1); PG8_BAR; PG8_SCHED;
            PG8_LDA(At, 1, 1); PG8_STAGE(PG8_SB(1, 0), b3, voffB); PG8_STAGE(PG8_SB(1, 1), b3 + hstep, voffB); PG8_STAGE_A(PG8_SA(1, 0), a3, 0, last);
            PG8_WAIT_V(8); PG8_WAIT_L(0); PG8_BAR; PG8_MMA(1, 0, At, B0); PG8_MMA(1, 1, At, B1); PG8_BAR; PG8_SCHED;
            } else {
            PG8_LDB(B0, 0, 0); PG8_SCHED; PG8_LDA(At, 0, 0); PG8_STAGE(PG8_SA(1, 1), a1 + hstep, voffA);
            PG8_WAIT_L(8); PG8_BAR; PG8_WAIT_L(0); PG8_MMA(0, 0, At, B0); PG8_BAR; PG8_SCHED;
            PG8_LDB(B1, 0, 1); PG8_STAGE(PG8_SB(0, 0), b2, voffB);
            PG8_BAR; PG8_WAIT_L(0); PG8_MMA(0, 1, At, B1); PG8_BAR;
            PG8_LDA(At, 0, 1); PG8_STAGE(PG8_SA(0, 0), a2, voffA);
            PG8_BAR; PG8_WAIT_L(0); PG8_MMA(1, 0, At, B0); PG8_BAR; PG8_SCHED;
            PG8_STAGE(PG8_SB(0, 1), b2 + hstep, voffB);
            PG8_WAIT_V(6); PG8_BAR; PG8_MMA(1, 1, At, B1); PG8_BAR;
            PG8_LDB(B0, 1, 0); PG8_SCHED; PG8_LDA(At, 1, 0); PG8_STAGE(PG8_SA(0, 1), a2 + hstep, voffA);
            PG8_WAIT_L(8); PG8_BAR; PG8_WAIT_L(0); PG8_MMA(0, 0, At, B0); PG8_BAR; PG8_SCHED;
            PG8_LDB(B1, 1, 1); PG8_STAGE(PG8_SB(1, 0), b3, voffB);
            PG8_BAR; PG8_WAIT_L(0); PG8_MMA(0, 1, At, B1); PG8_BAR;
            PG8_LDA(At, 1, 1); PG8_STAGE(PG8_SA(1, 0), a3, voffA);
            PG8_BAR; PG8_WAIT_L(0); PG8_MMA(1, 0, At, B0); PG8_BAR; PG8_SCHED;
            PG8_STAGE(PG8_SB(1, 1), b3 + hstep, voffB);
            PG8_WAIT_V(6); PG8_BAR; PG8_MMA(1, 1, At, B1); PG8_BAR;
            }
        }
        if constexpr (ALIGN_EPI) { if (wr == 0) PG8_BAR; }
        if constexpr (!Epi::AFTER_DRAIN) { E(acc, cur, wr, wc, fr, fq); S.done(cur); }
        if (!has_next) break;
#pragma unroll
        for (int a = 0; a < 2; ++a)
#pragma unroll
            for (int b = 0; b < 2; ++b)
#pragma unroll
                for (int m = 0; m < 4; ++m)
#pragma unroll
                    for (int n = 0; n < 2; ++n) acc[a][b][m][n] = (f32x4){0.f, 0.f, 0.f, 0.f};
        cur = nxt; cA = nA; cB = nB; ++ui;
        if constexpr (GATHER) { _Pragma("unroll") for (int h_ = 0; h_ < 2; ++h_) _Pragma("unroll") for (int i_ = 0; i_ < 2; ++i_) cvA[h_][i_] = nvA[h_][i_]; }
        if constexpr (ALIGN_EPI) { if (wr == 1) PG8_BAR; }
    }
    PG8_WAIT_V(0);
    if constexpr (!ALIGN_EPI) { if (wr == 0) PG8_BAR; }
    PG8_BAR;
    if constexpr (Epi::AFTER_DRAIN) { E.fused(acc, cur, wr, wc, fr, fq, lds, wid, lane); S.done(cur); }
#undef PG8_SA
#undef PG8_SB
#undef PG8_STAGE
#undef PG8_STAGE_A
#undef PG8_GFILL
#undef PG8_LDA
#undef PG8_LDB
#undef PG8_MMA
#undef PG8_WAIT_V
#undef PG8_WAIT_L
#undef PG8_BAR
#undef PG8_SCHED
}
}
namespace fa {
constexpr int D = 128, RS = 2048, KMIN = 112;
constexpr float THR = 8.f; constexpr bool WSKIP = false;
constexpr float SCALE = 0.08838834764831845f;
constexpr int NW = 8, QBLK = 32, KVBLK = 64, QB = NW * QBLK;
constexpr int SHM_V = KVBLK * D * 2, SHM_K = KVBLK * D * 2;
constexpr int LDS_CK = 2 * SHM_V + 2 * SHM_K + NW * 64 * 4, LDS_BYTES = LDS_CK + 2 * 64 * 4;

typedef unsigned short bf16;
typedef short bf16x8 __attribute__((ext_vector_type(8)));
typedef short s16x4 __attribute__((ext_vector_type(4)));
typedef float f32x16 __attribute__((ext_vector_type(16)));
typedef float f32x4 __attribute__((ext_vector_type(4)));
typedef unsigned u32x4 __attribute__((ext_vector_type(4)));
template <class A, class Bt> struct same_t { static constexpr bool v = false; };
template <class A> struct same_t<A, A> { static constexpr bool v = true; };

#define KSWZ(row, colB) ((row) * 256 + ((colB) ^ (((row) & 7) << 4)))
#define SBAR() __builtin_amdgcn_sched_barrier(0)
__device__ __forceinline__ int v_st(int k, int c) { const int kk = (k & ~0xC) | ((k & 4) << 1) | ((k & 8) >> 1); return ((kk >> 3) * 4 + (c >> 5)) * 512 + ((kk & 7) * 32 + (c & 31)) * 2; }
__device__ __forceinline__ int v_rd_base(int lane) { return ((lane & 3) << 3) | (((lane >> 2) & 3) << 6) | (((lane >> 4) & 1) << 5) | (((lane >> 5) & 1) << 8); }
constexpr int v_rd_off(int d0, int ks, int half) { return d0 * 512 + ks * 4096 + half * 2048; }
__device__ __forceinline__ int crow(int r, int hi) { return (r & 3) + 8 * (r >> 2) + 4 * hi; }
__device__ __forceinline__ unsigned cvtpk(float lo, float hi) {
    unsigned r; asm volatile("v_cvt_pk_bf16_f32 %0, %1, %2" : "=v"(r) : "v"(lo), "v"(hi)); return r;
}
__device__ __forceinline__ bf16x8 pack8(f32x4 a, f32x4 b) {
    u32x4 w = {cvtpk(a[0], a[1]), cvtpk(a[2], a[3]), cvtpk(b[0], b[1]), cvtpk(b[2], b[3])};
    return *reinterpret_cast<bf16x8*>(&w);
}
template <class T> __device__ __forceinline__ bf16x8 load8(const T* p) {
    if constexpr (same_t<T, float>::v) { return pack8(*(const f32x4*)p, *(const f32x4*)(p + 4)); }
    else { return *reinterpret_cast<const bf16x8*>(p); }
}
__device__ __forceinline__ void mask_tile(f32x16& p0, f32x16& p1, int dq, unsigned W) {
    const float NEG = -__builtin_inff();
#pragma unroll
    for (int r = 0; r < 16; ++r) {
        const int c = (r & 3) + 8 * (r >> 2);
        if ((unsigned)(dq - c) >= W) p0[r] = NEG;
        if ((unsigned)(dq - c - 32) >= W) p1[r] = NEG;
    }
}
__device__ __forceinline__ void partialSM(f32x16& p0, f32x16& p1, float& m_reg, float& mn, float& alpha) {
    float pmax = p0[0]; for (int r = 1; r < 16; ++r) pmax = fmaxf(pmax, p0[r]); for (int r = 0; r < 16; ++r) pmax = fmaxf(pmax, p1[r]);
    { auto rr = __builtin_amdgcn_permlane32_swap(__float_as_uint(pmax), __float_as_uint(pmax), false, false);
      pmax = fmaxf(__uint_as_float(rr[0]), __uint_as_float(rr[1])); }
    constexpr float C2 = 1.4426950408889634f * SCALE;
    if (__builtin_expect(__all((pmax - m_reg) * SCALE <= THR), 1)) { mn = m_reg; alpha = 1.f; }
    else { mn = fmaxf(m_reg, pmax); alpha = __builtin_amdgcn_exp2f((m_reg - mn) * C2); m_reg = mn; }
    const float mnL = -mn * C2;
    for (int r = 0; r < 16; ++r) p0[r] = fmaf(p0[r], C2, mnL); for (int r = 0; r < 16; ++r) p1[r] = fmaf(p1[r], C2, mnL);
    for (int r = 0; r < 16; ++r) p0[r] = __builtin_amdgcn_exp2f(p0[r]);
}
__device__ __forceinline__ void finishSM(f32x16& p0, f32x16& p1, float alpha, float& l_reg, bf16x8& pa0, bf16x8& pa1, bf16x8& pa2, bf16x8& pa3) {
    for (int r = 0; r < 16; ++r) p1[r] = __builtin_amdgcn_exp2f(p1[r]);
    float ps = 0; for (int r = 0; r < 16; ++r) ps += p0[r]; for (int r = 0; r < 16; ++r) ps += p1[r];
    { auto rr = __builtin_amdgcn_permlane32_swap(__float_as_uint(ps), __float_as_uint(ps), false, false);
      ps = __uint_as_float(rr[0]) + __uint_as_float(rr[1]); }
    l_reg = l_reg * alpha + ps;
#define PK4(P, B_, OUT) do { unsigned a0 = cvtpk(P[B_+0], P[B_+1]), a1 = cvtpk(P[B_+2], P[B_+3]);                          \
        unsigned b0 = cvtpk(P[B_+4], P[B_+5]), b1 = cvtpk(P[B_+6], P[B_+7]);                                             \
        auto r0 = __builtin_amdgcn_permlane32_swap(a0, b0, false, false); auto r1 = __builtin_amdgcn_permlane32_swap(a1, b1, false, false); \
        u32x4 w = {r0[0], r1[0], r0[1], r1[1]}; OUT = *reinterpret_cast<bf16x8*>(&w); } while (0)
    PK4(p0, 0, pa0); PK4(p0, 8, pa1); PK4(p1, 0, pa2); PK4(p1, 8, pa3);
#undef PK4
}
template <int KB, bool SK>
__device__ __forceinline__ void qkt(f32x16& p0, f32x16& p1, const char* K_lds, int r32, int hi, const bf16x8* qr, bool act, const float* ck_l) {
    if (SK && !act) { const float NEG = -__builtin_inff();
#pragma unroll
        for (int r = 0; r < 16; ++r) { p0[r] = NEG; p1[r] = NEG; } return; }
    { const float* cb = ck_l + KB * 64 + 4 * hi;
#pragma unroll
      for (int g = 0; g < 4; ++g) { const f32x4 c0 = *(const f32x4*)(cb + 8 * g), c1 = *(const f32x4*)(cb + 32 + 8 * g);
#pragma unroll
          for (int e = 0; e < 4; ++e) { p0[4 * g + e] = c0[e]; p1[4 * g + e] = c1[e]; } } }
    const char* kb[4];
#pragma unroll
    for (int dd = 0; dd < 4; ++dd) kb[dd] = K_lds + KB * SHM_K + KSWZ(r32, (dd * 16 + hi * 8) * 2);
    bf16x8 kf0[8], kf1[8];
#pragma unroll
    for (int d0 = 0; d0 < 8; ++d0) { const char* a = kb[d0 & 3] + (d0 >> 2) * 128;
        kf0[d0] = *reinterpret_cast<const bf16x8*>(a); kf1[d0] = *reinterpret_cast<const bf16x8*>(a + 32 * 256); }
    asm volatile("s_waitcnt lgkmcnt(0)" ::: "memory"); SBAR();
#pragma unroll
    for (int d0 = 0; d0 < 8; ++d0) {
        p0 = __builtin_amdgcn_mfma_f32_32x32x16_bf16(kf0[d0], qr[d0], p0, 0, 0, 0);
        p1 = __builtin_amdgcn_mfma_f32_32x32x16_bf16(kf1[d0], qr[d0], p1, 0, 0, 0); }
}
template <int VB, bool SK>
__device__ __forceinline__ void pv_tile(f32x16* o, int vb0, bf16x8 pa0, bf16x8 pa1, bf16x8 pa2, bf16x8 pa3, bool act) {
    if (SK && !act) return;
#define TRRD(dst, off) asm volatile("ds_read_b64_tr_b16 %0, %1 offset:%2" : "=&v"(dst) : "v"(vb0), "i"(off) : "memory")
#define PV_D0(d0) do { s16x4 l0, l1, l2, l3, h0, h1, h2, h3; constexpr int b_ = VB * SHM_V + v_rd_off(d0, 0, 0);     \
        TRRD(l0, b_); TRRD(h0, b_ + 2048); TRRD(l1, b_ + 4096); TRRD(h1, b_ + 6144); TRRD(l2, b_ + 8192); TRRD(h2, b_ + 10240); TRRD(l3, b_ + 12288); TRRD(h3, b_ + 14336); \
        asm volatile("s_waitcnt lgkmcnt(0)" ::: "memory"); SBAR();                 \
        o[d0] = __builtin_amdgcn_mfma_f32_32x32x16_bf16(pa0, (bf16x8){l0[0], l0[1], l0[2], l0[3], h0[0], h0[1], h0[2], h0[3]}, o[d0], 0, 0, 0);   \
        o[d0] = __builtin_amdgcn_mfma_f32_32x32x16_bf16(pa1, (bf16x8){l1[0], l1[1], l1[2], l1[3], h1[0], h1[1], h1[2], h1[3]}, o[d0], 0, 0, 0);   \
        o[d0] = __builtin_amdgcn_mfma_f32_32x32x16_bf16(pa2, (bf16x8){l2[0], l2[1], l2[2], l2[3], h2[0], h2[1], h2[2], h2[3]}, o[d0], 0, 0, 0);   \
        o[d0] = __builtin_amdgcn_mfma_f32_32x32x16_bf16(pa3, (bf16x8){l3[0], l3[1], l3[2], l3[3], h3[0], h3[1], h3[2], h3[3]}, o[d0], 0, 0, 0); } while (0)
    PV_D0(0); PV_D0(1); PV_D0(2); PV_D0(3);
#undef PV_D0
#undef TRRD
}

struct PlainBlock { const bf16* Q; const bf16* K; const bf16* V; bf16* O; const float* C; int P0; };
__device__ __forceinline__ void attn_plain_block(const PlainBlock& B, char* lds, int wave_sgpr) {
    const int lane = mk_lane_id(), wid = wave_sgpr, tid = wid * 64 + lane, r32 = lane & 31, hi = lane >> 5;
    const int rbk = wid < 4 ? wid : 11 - wid;
    char* V_lds = lds; char* K_lds = lds + 2 * SHM_V;
    float* ws = (float*)(lds + 2 * SHM_V + 2 * SHM_K) + wid * 64; float* li_l = ws, * al_l = ws + 32; float* ck_l = (float*)(lds + LDS_CK);
    const int sr = tid >> 4, sc = (tid & 15) * 8, vst0 = v_st(sr, sc), vst1 = v_st(32 + sr, sc), kws = KSWZ(sr, sc * 2);
    const int vb0 = (int)(uintptr_t)V_lds + v_rd_base(lane);
    const int qlo = B.P0 + rbk * QBLK, qm = qlo + r32 - 4 * hi;
    const unsigned Wl = (unsigned)(qlo + r32 - (KMIN - 1));
    const int j_lo = KMIN / KVBLK, j_hi = (B.P0 + QB - 1) / KVBLK + 1, NT = j_hi - j_lo;
    bf16x8 qr[8];
#pragma unroll
    for (int d0 = 0; d0 < 8; ++d0) qr[d0] = load8<bf16>(B.Q + (size_t)(rbk * QBLK + r32) * RS + d0 * 16 + hi * 8);
    float m_reg = -1e30f, l_reg = 0.f; f32x16 o[4] = {};
    bf16x8 sk0, sk1, sv0, sv1; float scv;
#define PL_LOAD(k0) do { const bf16* kp_ = B.K + (size_t)((k0) + sr) * RS + sc; const bf16* vp_ = B.V + (size_t)((k0) + sr) * RS + sc; \
        sk0 = load8<bf16>(kp_); sk1 = load8<bf16>(kp_ + (size_t)32 * RS); sv0 = load8<bf16>(vp_); sv1 = load8<bf16>(vp_ + (size_t)32 * RS); scv = B.C[(k0) + lane]; } while (0)
#define PL_WRITE(bf) do { *(bf16x8*)(K_lds + (bf) * SHM_K + kws) = sk0; *(bf16x8*)(K_lds + (bf) * SHM_K + kws + 32 * 256) = sk1; \
        *(bf16x8*)(V_lds + (bf) * SHM_V + vst0) = sv0; *(bf16x8*)(V_lds + (bf) * SHM_V + vst1) = sv1; if (wid == 0) ck_l[(bf) * 64 + lane] = scv; } while (0)
#define PL_STEP(t, BUF) do { const int kb_ = (j_lo + NT - 1 - (t)) * KVBLK; const bool more_ = (t) + 1 < NT;                           \
        if (more_) PL_LOAD(kb_ - KVBLK);                                                                                                 \
        if (kb_ <= qlo + QBLK - 1) {                                                \
            f32x16 p0, p1; float mn, alpha; bf16x8 pa0, pa1, pa2, pa3;                                                                   \
            qkt<BUF, false>(p0, p1, K_lds, r32, hi, qr, true, ck_l);                                                                     \
            if (kb_ + KVBLK - 1 > qlo || kb_ < KMIN) mask_tile(p0, p1, qm - kb_, Wl);                                                    \
            partialSM(p0, p1, m_reg, mn, alpha);                                                                                         \
            if (__any(alpha < 1.f)) { if (hi == 0) al_l[r32] = alpha; asm volatile("s_waitcnt lgkmcnt(0)" ::: "memory");                 \
                _Pragma("unroll") for (int d_ = 0; d_ < 4; ++d_) _Pragma("unroll") for (int r = 0; r < 16; ++r) o[d_][r] *= al_l[crow(r, hi)]; } \
            finishSM(p0, p1, alpha, l_reg, pa0, pa1, pa2, pa3); SBAR();                                                                  \
            pv_tile<BUF, false>(o, vb0, pa0, pa1, pa2, pa3, true); }                                                                     \
        if (more_) PL_WRITE((BUF) ^ 1);                                                                                                  \
        __syncthreads(); } while (0)
    PL_LOAD((j_lo + NT - 1) * KVBLK); PL_WRITE(0);
    __syncthreads();
    _Pragma("nounroll") for (int t = 0; t < NT; t += 2) { PL_STEP(t, 0); if (t + 1 < NT) PL_STEP(t + 1, 1); }
    if (hi == 0) li_l[r32] = l_reg; asm volatile("s_waitcnt lgkmcnt(0)" ::: "memory");
    bf16* Ow = B.O + (size_t)(rbk * QBLK) * RS;
#pragma unroll
    for (int r = 0; r < 16; ++r) { const int orow = crow(r, hi); const float rl = __builtin_amdgcn_rcpf(li_l[orow]);
#pragma unroll
        for (int d0 = 0; d0 < 4; ++d0) { const float v = o[d0][r] * rl; const float vn = __shfl_xor(v, 1);
            if ((r32 & 1) == 0) *(unsigned*)(Ow + (size_t)orow * RS + d0 * 32 + r32) = cvtpk(v, vn); } }
    __syncthreads();
#undef PL_LOAD
#undef PL_WRITE
#undef PL_STEP
}
__device__ __forceinline__ void attn_dma_block(const PlainBlock& B, char* lds, int wave_sgpr) {
    const int lane = mk_lane_id(), wid = wave_sgpr, tid = wid * 64 + lane, r32 = lane & 31, hi = lane >> 5;
    const int rbk = wid < 4 ? wid : 11 - wid;
    char* V_lds = lds; char* K_lds = lds + 2 * SHM_V;
    float* ws = (float*)(lds + 2 * SHM_V + 2 * SHM_K) + wid * 64; float* li_l = ws, * al_l = ws + 32; float* ck_l = (float*)(lds + LDS_CK);
    unsigned koff[2], voff[2];
#pragma unroll
    for (int i = 0; i < 2; ++i) { const int j_ = 2 * wid + i, kr = 4 * j_ + (lane >> 4), kc = (lane & 15) ^ (kr & 7); koff[i] = (unsigned)(kr * (RS * 2) + kc * 16);
        const int st = 2 * j_ + (lane >> 5), kk = ((st >> 2) << 3) | ((lane & 31) >> 2), vk = (kk & ~0xC) | ((kk & 4) << 1) | ((kk & 8) >> 1), vc = (st & 3) * 32 + 8 * (lane & 3); voff[i] = (unsigned)(vk * (RS * 2) + vc * 2); }
    const unsigned kl0 = (unsigned)(uintptr_t)K_lds + (unsigned)wid * 2048u, vl0 = (unsigned)(uintptr_t)V_lds + (unsigned)wid * 2048u;
    const int vb0 = (int)(uintptr_t)V_lds + v_rd_base(lane);
    const int qlo = B.P0 + rbk * QBLK, qm = qlo + r32 - 4 * hi;
    const unsigned Wl = (unsigned)(qlo + r32 - (KMIN - 1));
    const int j_lo = KMIN / KVBLK, j_hi = (B.P0 + QB - 1) / KVBLK + 1, NT = j_hi - j_lo;
    bf16x8 qr[8];
#pragma unroll
    for (int d0 = 0; d0 < 8; ++d0) qr[d0] = load8<bf16>(B.Q + (size_t)(rbk * QBLK + r32) * RS + d0 * 16 + hi * 8);
    float m_reg = -1e30f, l_reg = 0.f; f32x16 o[4] = {};
    float scv;
#define PL_DMA(k0, bf) do { const char* kg_ = (const char*)(B.K + (size_t)(k0) * RS); const char* vg_ = (const char*)(B.V + (size_t)(k0) * RS);                           \
        _Pragma("unroll") for (int i_ = 0; i_ < 2; ++i_) {                                                                                                          \
            __builtin_amdgcn_global_load_lds((const unsigned*)(kg_ + koff[i_]), (__attribute__((address_space(3))) unsigned*)(uintptr_t)(kl0 + (bf) * SHM_K + i_ * 1024), 16, 0, 0); \
            __builtin_amdgcn_global_load_lds((const unsigned*)(vg_ + voff[i_]), (__attribute__((address_space(3))) unsigned*)(uintptr_t)(vl0 + (bf) * SHM_V + i_ * 1024), 16, 0, 0); } \
        scv = B.C[(k0) + lane]; } while (0)
#define PL_FIN(bf) do { if (wid == 0) ck_l[(bf) * 64 + lane] = scv; asm volatile("s_waitcnt vmcnt(0)" ::: "memory"); } while (0)
#define PL_STEP(t, BUF) do { const int kb_ = (j_lo + NT - 1 - (t)) * KVBLK; const bool more_ = (t) + 1 < NT;                           \
        if (more_) PL_DMA(kb_ - KVBLK, (BUF) ^ 1);                                                                                              \
        if (kb_ <= qlo + QBLK - 1) {                                                \
            f32x16 p0, p1; float mn, alpha; bf16x8 pa0, pa1, pa2, pa3;                                                                   \
            qkt<BUF, false>(p0, p1, K_lds, r32, hi, qr, true, ck_l);                                                                     \
            if (kb_ + KVBLK - 1 > qlo || kb_ < KMIN) mask_tile(p0, p1, qm - kb_, Wl);                                                    \
            partialSM(p0, p1, m_reg, mn, alpha);                                                                                         \
            if (__any(alpha < 1.f)) { if (hi == 0) al_l[r32] = alpha; asm volatile("s_waitcnt lgkmcnt(0)" ::: "memory");                 \
                _Pragma("unroll") for (int d_ = 0; d_ < 4; ++d_) _Pragma("unroll") for (int r = 0; r < 16; ++r) o[d_][r] *= al_l[crow(r, hi)]; } \
            finishSM(p0, p1, alpha, l_reg, pa0, pa1, pa2, pa3); SBAR();                                                                  \
            pv_tile<BUF, false>(o, vb0, pa0, pa1, pa2, pa3, true); }                                                                     \
        if (more_) PL_FIN((BUF) ^ 1);                                                                                                    \
        __syncthreads(); } while (0)
    PL_DMA((j_lo + NT - 1) * KVBLK, 0); PL_FIN(0);
    __syncthreads();
    _Pragma("nounroll") for (int t = 0; t < NT; t += 2) { PL_STEP(t, 0); if (t + 1 < NT) PL_STEP(t + 1, 1); }
    if (hi == 0) li_l[r32] = l_reg; asm volatile("s_waitcnt lgkmcnt(0)" ::: "memory");
    bf16* Ow = B.O + (size_t)(rbk * QBLK) * RS;
#pragma unroll
    for (int r = 0; r < 16; ++r) { const int orow = crow(r, hi); const float rl = __builtin_amdgcn_rcpf(li_l[orow]);
#pragma unroll
        for (int d0 = 0; d0 < 4; ++d0) { const float v = o[d0][r] * rl; const float vn = __shfl_xor(v, 1);
            if ((r32 & 1) == 0) *(unsigned*)(Ow + (size_t)orow * RS + d0 * 32 + r32) = cvtpk(v, vn); } }
    __syncthreads();
#undef PL_DMA
#undef PL_FIN
#undef PL_STEP
}
__device__ __forceinline__ void attn_pipe_block(const PlainBlock& B, char* lds, int wave_sgpr) {
    const int lane = mk_lane_id(), wid = wave_sgpr, tid = wid * 64 + lane, r32 = lane & 31, hi = lane >> 5;
    char* V_lds = lds; char* K_lds = lds + 2 * SHM_V;
    float* ws = (float*)(lds + 2 * SHM_V + 2 * SHM_K) + wid * 64; float* li_l = ws, * al_l = ws + 32; float* ck_l = (float*)(lds + LDS_CK);
    const int sr = tid >> 4, sc = (tid & 15) * 8, vst0 = v_st(sr, sc), vst1 = v_st(32 + sr, sc), kws = KSWZ(sr, sc * 2);
    const int vb0 = (int)(uintptr_t)V_lds + v_rd_base(lane);
    const int qlo = B.P0 + wid * QBLK, qm = qlo + r32 - 4 * hi;
    const unsigned Wl = (unsigned)(qlo + r32 - (KMIN - 1));
    const int j_lo = KMIN / KVBLK, j_hi = (B.P0 + QB - 1) / KVBLK + 1, NT = j_hi - j_lo;
    bf16x8 qr[8];
#pragma unroll
    for (int d0 = 0; d0 < 8; ++d0) qr[d0] = load8<bf16>(B.Q + (size_t)(wid * QBLK + r32) * RS + d0 * 16 + hi * 8);
    float m_reg = -1e30f, l_reg = 0.f; f32x16 o[4] = {};
    bf16x8 sk0, sk1, sv0, sv1; float scv;
#define PP_LOADK(k0) do { const bf16* kp_ = B.K + (size_t)((k0) + sr) * RS + sc; sk0 = load8<bf16>(kp_); sk1 = load8<bf16>(kp_ + (size_t)32 * RS); scv = B.C[(k0) + lane]; } while (0)
#define PP_LOADV(k0) do { const bf16* vp_ = B.V + (size_t)((k0) + sr) * RS + sc; sv0 = load8<bf16>(vp_); sv1 = load8<bf16>(vp_ + (size_t)32 * RS); } while (0)
#define PP_WRITEK(bf) do { *(bf16x8*)(K_lds + (bf) * SHM_K + kws) = sk0; *(bf16x8*)(K_lds + (bf) * SHM_K + kws + 32 * 256) = sk1; if (wid == 0) ck_l[(bf) * 64 + lane] = scv; } while (0)
#define PP_WRITEV(bf) do { *(bf16x8*)(V_lds + (bf) * SHM_V + vst0) = sv0; *(bf16x8*)(V_lds + (bf) * SHM_V + vst1) = sv1; } while (0)
#define PP_KB(t) ((j_lo + (t)) * KVBLK)
#define PP_ACT(t) (PP_KB(t) <= qlo + QBLK - 1)
    PP_LOADK(PP_KB(0)); PP_LOADV(PP_KB(0)); PP_WRITEK(0); PP_WRITEV(0);
    if (NT > 1) { PP_LOADK(PP_KB(1)); PP_WRITEK(1); }
    __syncthreads();
    f32x16 pA0, pA1, pB0, pB1;
    qkt<0, false>(pA0, pA1, K_lds, r32, hi, qr, true, ck_l);
    __syncthreads();
#define PP_STEP(t, BUF, PC0, PC1, PN0, PN1) do { const int kb_ = PP_KB(t);                                                              \
        if ((t) + 2 < NT) PP_LOADK(PP_KB((t) + 2));                                                                                     \
        if ((t) + 1 < NT) PP_LOADV(PP_KB((t) + 1));                                                                                     \
        if ((t) + 1 < NT) qkt<(BUF) ^ 1, false>(PN0, PN1, K_lds, r32, hi, qr, true, ck_l);                           \
        {                                                                                                                               \
            float mn, alpha; bf16x8 pa0, pa1, pa2, pa3;                                                                                 \
            if (kb_ + KVBLK - 1 > qlo || kb_ < KMIN) mask_tile(PC0, PC1, qm - kb_, Wl);                                                 \
            partialSM(PC0, PC1, m_reg, mn, alpha);                                                                                      \
            if (__any(alpha < 1.f)) { if (hi == 0) al_l[r32] = alpha; asm volatile("s_waitcnt lgkmcnt(0)" ::: "memory");                \
                _Pragma("unroll") for (int d_ = 0; d_ < 4; ++d_) _Pragma("unroll") for (int r = 0; r < 16; ++r) o[d_][r] *= al_l[crow(r, hi)]; } \
            finishSM(PC0, PC1, alpha, l_reg, pa0, pa1, pa2, pa3); SBAR();                                                               \
            pv_tile<BUF, false>(o, vb0, pa0, pa1, pa2, pa3, true); }                                                                    \
        if ((t) + 2 < NT) PP_WRITEK(BUF);                                                                                               \
        if ((t) + 1 < NT) PP_WRITEV((BUF) ^ 1);                                                                                         \
        __syncthreads(); } while (0)
    _Pragma("nounroll") for (int t = 0; t < NT; t += 2) { PP_STEP(t, 0, pA0, pA1, pB0, pB1); if (t + 1 < NT) PP_STEP(t + 1, 1, pB0, pB1, pA0, pA1); }
    if (hi == 0) li_l[r32] = l_reg; asm volatile("s_waitcnt lgkmcnt(0)" ::: "memory");
    bf16* Ow = B.O + (size_t)(wid * QBLK) * RS;
#pragma unroll
    for (int r = 0; r < 16; ++r) { const int orow = crow(r, hi); const float rl = __builtin_amdgcn_rcpf(li_l[orow]);
#pragma unroll
        for (int d0 = 0; d0 < 4; ++d0) { const float v = o[d0][r] * rl; const float vn = __shfl_xor(v, 1);
            if ((r32 & 1) == 0) *(unsigned*)(Ow + (size_t)orow * RS + d0 * 32 + r32) = cvtpk(v, vn); } }
    __syncthreads();
#undef PP_LOADK
#undef PP_LOADV
#undef PP_WRITEK
#undef PP_WRITEV
#undef PP_KB
#undef PP_ACT
#undef PP_STEP
}
constexpr int P2_WS = 131072 + 2048, P2_CK = P2_WS + NW * 64 * 4;
__device__ __forceinline__ void attn_plain2_block(const PlainBlock& B, char* lds, int wave_sgpr) {
    const int lane = mk_lane_id(), wid = wave_sgpr, tid = wid * 64 + lane, r32 = lane & 31, hi = lane >> 5;
    char* V_lds = lds; char* K_lds = lds + 4 * SHM_V;
    float* ws = (float*)(lds + P2_WS) + wid * 64; float* li_l = ws, * al_l = ws + 32; float* ck_l = (float*)(lds + P2_CK);
    const int sr = tid >> 4, sc = (tid & 15) * 8, vst0 = v_st(sr, sc), vst1 = v_st(32 + sr, sc), kws = KSWZ(sr, sc * 2);
    const int vb0 = (int)(uintptr_t)V_lds + v_rd_base(lane);
    const int qlo = B.P0 + wid * QBLK, qm = qlo + r32 - 4 * hi;
    const unsigned Wl = (unsigned)(qlo + r32 - (KMIN - 1));
    const int j_lo = KMIN / KVBLK, j_hi = (B.P0 + QB - 1) / KVBLK + 1, NT = j_hi - j_lo, NS = (NT + 1) >> 1;
    bf16x8 qr[8];
#pragma unroll
    for (int d0 = 0; d0 < 8; ++d0) qr[d0] = load8<bf16>(B.Q + (size_t)(wid * QBLK + r32) * RS + d0 * 16 + hi * 8);
    float m_reg = -1e30f, l_reg = 0.f; f32x16 o[4] = {};
    bf16x8 ak0, ak1, av0, av1, bk0, bk1, bv0, bv1; float ac, bc;
#define Q2_LOAD(tt, K0, K1, V0, V1, CB_) do { const int t_ = (tt) < NT ? (tt) : NT - 1; const int k0_ = (j_lo + t_) * KVBLK;                              \
        const bf16* kp_ = B.K + (size_t)(k0_ + sr) * RS + sc; const bf16* vp_ = B.V + (size_t)(k0_ + sr) * RS + sc;                                   \
        K0 = load8<bf16>(kp_); K1 = load8<bf16>(kp_ + (size_t)32 * RS); V0 = load8<bf16>(vp_); V1 = load8<bf16>(vp_ + (size_t)32 * RS); CB_ = B.C[k0_ + lane]; } while (0)
#define Q2_WRITE(bf, K0, K1, V0, V1, CB_) do { *(bf16x8*)(K_lds + (bf) * SHM_K + kws) = K0; *(bf16x8*)(K_lds + (bf) * SHM_K + kws + 32 * 256) = K1;     \
        *(bf16x8*)(V_lds + (bf) * SHM_V + vst0) = V0; *(bf16x8*)(V_lds + (bf) * SHM_V + vst1) = V1; if (wid == 0) ck_l[(bf) * 64 + lane] = CB_; } while (0)
#define Q2_TILE(tt, BUF) do { const int kb_ = (j_lo + (tt)) * KVBLK;                                                                                 \
        if ((tt) < NT && kb_ <= qlo + QBLK - 1) {                                                                                                    \
            f32x16 p0, p1; float mn, alpha; bf16x8 pa0, pa1, pa2, pa3;                                                                               \
            qkt<BUF, false>(p0, p1, K_lds, r32, hi, qr, true, ck_l);                                                                                 \
            if (kb_ + KVBLK - 1 > qlo || kb_ < KMIN) mask_tile(p0, p1, qm - kb_, Wl);                                                                \
            partialSM(p0, p1, m_reg, mn, alpha);                                                                                                     \
            if (__any(alpha < 1.f)) { if (hi == 0) al_l[r32] = alpha; asm volatile("s_waitcnt lgkmcnt(0)" ::: "memory");                             \
                _Pragma("unroll") for (int d_ = 0; d_ < 4; ++d_) _Pragma("unroll") for (int r = 0; r < 16; ++r) o[d_][r] *= al_l[crow(r, hi)]; }     \
            finishSM(p0, p1, alpha, l_reg, pa0, pa1, pa2, pa3); SBAR();                                                                              \
            pv_tile<BUF, false>(o, vb0, pa0, pa1, pa2, pa3, true); } } while (0)
#define Q2_STEP(s_, PB) do {                                                                                                                         \
        Q2_LOAD(2 * (s_) + 2, ak0, ak1, av0, av1, ac); Q2_LOAD(2 * (s_) + 3, bk0, bk1, bv0, bv1, bc);                                                 \
        Q2_TILE(2 * (s_), 2 * (PB)); Q2_TILE(2 * (s_) + 1, 2 * (PB) + 1);                                                                            \
        if (2 * (s_) + 2 < NT) { Q2_WRITE(2 * ((PB) ^ 1), ak0, ak1, av0, av1, ac); if (2 * (s_) + 3 < NT) Q2_WRITE(2 * ((PB) ^ 1) + 1, bk0, bk1, bv0, bv1, bc); } \
        __syncthreads(); } while (0)
    Q2_LOAD(0, ak0, ak1, av0, av1, ac); Q2_LOAD(1, bk0, bk1, bv0, bv1, bc);
    Q2_WRITE(0, ak0, ak1, av0, av1, ac); if (NT > 1) Q2_WRITE(1, bk0, bk1, bv0, bv1, bc);
    __syncthreads();
    _Pragma("nounroll") for (int s = 0; s < NS; s += 2) { Q2_STEP(s, 0); if (s + 1 < NS) Q2_STEP(s + 1, 1); }
    if (hi == 0) li_l[r32] = l_reg; asm volatile("s_waitcnt lgkmcnt(0)" ::: "memory");
    bf16* Ow = B.O + (size_t)(wid * QBLK) * RS;
#pragma unroll
    for (int r = 0; r < 16; ++r) { const int orow = crow(r, hi); const float rl = __builtin_amdgcn_rcpf(li_l[orow]);
#pragma unroll
        for (int d0 = 0; d0 < 4; ++d0) { const float v = o[d0][r] * rl; const float vn = __shfl_xor(v, 1);
            if ((r32 & 1) == 0) *(unsigned*)(Ow + (size_t)orow * RS + d0 * 32 + r32) = cvtpk(v, vn); } }
    __syncthreads();
#undef Q2_LOAD
#undef Q2_WRITE
#undef Q2_TILE
#undef Q2_STEP
}
}
namespace rt {
#define RT_LAS __attribute__((address_space(3)))
typedef short bf16x8 __attribute__((ext_vector_type(8)));
typedef short s16x4 __attribute__((ext_vector_type(4)));
typedef float f32x16 __attribute__((ext_vector_type(16)));
typedef unsigned u32x4 __attribute__((ext_vector_type(4)));
typedef unsigned u32x2 __attribute__((ext_vector_type(2)));
__device__ __forceinline__ unsigned off_b(unsigned row, unsigned ch) { return 256u * row + 16u * (ch ^ (((row & 3u) << 2) | ((row >> 2) & 3u))); }
__device__ __forceinline__ unsigned cvtpk(float lo, float hi) { unsigned r; asm volatile("v_cvt_pk_bf16_f32 %0, %1, %2" : "=v"(r) : "v"(lo), "v"(hi)); return r; }
__device__ __forceinline__ bf16x8 rowfrag(RT_LAS const char* tile, unsigned row0, unsigned s, unsigned lane) {
    return *(RT_LAS const bf16x8*)(tile + off_b(row0 + (lane & 31u), 2u * s + (lane >> 5)));
}
__device__ __forceinline__ unsigned trbase(unsigned lane, unsigned c) {
    const unsigned h = lane >> 5, blk = (lane >> 4) & 1u, q = (lane & 15u) >> 2, p = lane & 3u;
    return off_b(8u * h + q, 4u * c + 2u * blk + (p >> 1)) + 8u * (p & 1u);
}
__device__ __forceinline__ bf16x8 trfrag(RT_LAS const char* tile, unsigned base, unsigned ks) {
    const s16x4 lo = __builtin_amdgcn_ds_read_tr16_b64_v4i16((RT_LAS s16x4*)(tile + base + 4096u * ks));
    const s16x4 hi = __builtin_amdgcn_ds_read_tr16_b64_v4i16((RT_LAS s16x4*)(tile + (base ^ 16u) + 1024u + 4096u * ks));
    return (bf16x8){lo[0], lo[1], lo[2], lo[3], hi[0], hi[1], hi[2], hi[3]};
}
#define RT_PK4(P, B_, OUT) do { unsigned a0_ = cvtpk(P[B_+0], P[B_+1]), a1_ = cvtpk(P[B_+2], P[B_+3]); unsigned b0_ = cvtpk(P[B_+4], P[B_+5]), b1_ = cvtpk(P[B_+6], P[B_+7]); \
        auto r0_ = __builtin_amdgcn_permlane32_swap(a0_, b0_, false, false); auto r1_ = __builtin_amdgcn_permlane32_swap(a1_, b1_, false, false); \
        u32x4 w_ = {r0_[0], r1_[0], r0_[1], r1_[1]}; OUT = *reinterpret_cast<bf16x8*>(&w_); } while (0)
#define RT_MFMA(a, b, c) __builtin_amdgcn_mfma_f32_32x32x16_bf16(a, b, c, 0, 0, 0)
#define RT_WAIT() do { asm volatile("s_waitcnt lgkmcnt(0)" ::: "memory"); __builtin_amdgcn_sched_barrier(0); } while (0)

__device__ __forceinline__ void phase_retention(const unsigned short* Q, const unsigned short* K, unsigned short* V, RT_LAS unsigned char* lds_u, int nb, int lp, int wave_sgpr, bool dry = false) {
    RT_LAS char* Kimg = (RT_LAS char*)lds_u; RT_LAS char* Vimg = Kimg + 65536; RT_LAS char* Timg = Kimg + 98304;
    const unsigned lane = (unsigned)mk_lane_id(), wid = (unsigned)wave_sgpr, tid = wid * 64u + lane, r32 = lane & 31u, hi = lane >> 5;
    const unsigned ib = wid < 4u ? wid >> 1 : 3u - ((wid - 4u) >> 1), eb = wid & 1u;
    const int nchunk = lp / 128;
    _Pragma("nounroll") for (int unit = blockIdx.x; unit < nb * 64; unit += gridDim.x) {
        int bh, es; if ((gridDim.x & 7) == 0 && nb * 8 == 32) { const int cls = unit & 7, r = (unit >> 3) & 31; bh = cls * 4 + (r >> 3); es = r & 7; } else { bh = unit >> 3; es = unit & 7; }
        const int b = bh >> 3, h = bh & 7;
        const float l2g = __log2f(1.0f - exp2f(-5.0f - (float)h)), gC = exp2f(128.0f * l2g);
        const float rowfac = exp2f(((float)(32u * ib + r32) - 127.0f) * l2g);
        f32x16 ST0 = {}, ST1 = {};
        __syncthreads();
        { u32x4 z = {0u, 0u, 0u, 0u};
#pragma unroll
          for (int i = 0; i < 4; ++i) *(RT_LAS u32x4*)(Timg + (tid + 512u * i) * 16u) = z; }
        u32x4 kpre[8], vpre[2]; bf16x8 qr[16];
#define RT_LOAD_KV(rb_) do { const char* kb_ = (const char*)(K + (rb_) * 2048 + h * 256); const char* vb_ = (const char*)(V + (rb_) * 4096 + h * 512 + es * 64);     \
        unsigned t_ = tid; asm volatile("" : "+v"(t_));     \
        const unsigned ko_ = (t_ >> 5) * 4096u + (t_ & 31u) * 16u, vo_ = (t_ >> 3) * 8192u + (t_ & 7u) * 16u; \
        _Pragma("unroll") for (int i = 0; i < 8; ++i) kpre[i] = *(const u32x4*)(kb_ + (size_t)i * 65536 + ko_); \
        _Pragma("unroll") for (int i = 0; i < 2; ++i) vpre[i] = *(const u32x4*)(vb_ + (size_t)i * 524288 + vo_); } while (0)
#define RT_LOAD_Q(rb_) do { const char* qb_ = (const char*)(Q + ((((rb_) + 32u * ib) >> 5) * 8 + h) * (size_t)8192); unsigned l_ = lane; asm volatile("" : "+v"(l_)); _Pragma("unroll") for (int s = 0; s < 16; ++s) qr[s] = *(const bf16x8*)(qb_ + 1024 * s + 16u * l_); } while (0)
#define RT_LOAD_QH(rb_, h0_) do { const char* qb_ = (const char*)(Q + ((((rb_) + 32u * ib) >> 5) * 8 + h) * (size_t)8192); unsigned l_ = lane; asm volatile("" : "+v"(l_)); _Pragma("unroll") for (int s = 0; s < 8; ++s) qr[8 * (h0_) + s] = *(const bf16x8*)(qb_ + 1024 * (8 * (h0_) + s) + 16u * l_); } while (0)
        { const size_t rb0 = (size_t)b * lp; RT_LOAD_KV(rb0); RT_LOAD_Q(rb0); }
        _Pragma("nounroll") for (int c = 0; c < nchunk; ++c) {
            const size_t rowbase = (size_t)b * lp + (size_t)c * 128;
            __syncthreads();
#pragma unroll
            for (int i = 0; i < 8; ++i) { const unsigned idx = tid + 512u * i, j = idx >> 5, ch = idx & 31u;
                *(RT_LAS u32x4*)(Kimg + (ch >> 4) * 32768u + off_b(j, ch & 15u)) = kpre[i]; }
#pragma unroll
            for (int i = 0; i < 2; ++i) { const unsigned idx = tid + 512u * i, j = idx >> 3, ch = idx & 7u;
                *(RT_LAS u32x4*)(Vimg + off_b(j, ch)) = vpre[i]; }
            __syncthreads();
            f32x16 acc0 = {}, acc1 = {};
            unsigned lo_ = lane; asm volatile("" : "+v"(lo_));
            const unsigned v0b = trbase(lo_, 0u), v1b = trbase(lo_, 1u), tbase0 = trbase(lo_, eb), tbase1 = trbase(lo_, 2u + eb);
#pragma unroll
            for (unsigned jb = 0; jb < 4; ++jb) if (jb <= ib && (jb & 1u) == eb) {
                f32x16 sp = {};
#pragma unroll
                for (unsigned hh = 0; hh < 2; ++hh) { bf16x8 kf[8];
#pragma unroll
                    for (unsigned s = 0; s < 8; ++s) kf[s] = rowfrag(Kimg + hh * 32768u, 32u * jb, s, lo_);
                    RT_WAIT();
#pragma unroll
                    for (unsigned s = 0; s < 8; ++s) sp = RT_MFMA(kf[s], qr[8u * hh + s], sp);
                    __builtin_amdgcn_sched_barrier(0); }
                if (jb == ib) {
#pragma unroll
                    for (unsigned r = 0; r < 16; ++r) if ((r & 3u) + 8u * (r >> 2) + 4u * hi > r32) sp[r] = 0.f;
                }
                bf16x8 pa0, pa1; RT_PK4(sp, 0, pa0); RT_PK4(sp, 8, pa1);
                const bf16x8 va0 = trfrag(Vimg, v0b, 2u * jb), va1 = trfrag(Vimg, v0b, 2u * jb + 1u), vb0 = trfrag(Vimg, v1b, 2u * jb), vb1 = trfrag(Vimg, v1b, 2u * jb + 1u);
                RT_WAIT();
                acc0 = RT_MFMA(va0, pa0, acc0); acc0 = RT_MFMA(va1, pa1, acc0); acc1 = RT_MFMA(vb0, pa0, acc1); acc1 = RT_MFMA(vb1, pa1, acc1);
                __builtin_amdgcn_sched_barrier(0);
            }
#define RT_POST(OTH) do { RT_LAS char* xs = (RT_LAS char*)lds_u + 133120u + wid * 2048u + lane * 32u;        \
              u32x4 w0 = {cvtpk(OTH[0], OTH[1]), cvtpk(OTH[2], OTH[3]), cvtpk(OTH[4], OTH[5]), cvtpk(OTH[6], OTH[7])}, w1 = {cvtpk(OTH[8], OTH[9]), cvtpk(OTH[10], OTH[11]), cvtpk(OTH[12], OTH[13]), cvtpk(OTH[14], OTH[15])}; \
              *(RT_LAS u32x4*)xs = w0; *(RT_LAS u32x4*)(xs + 16) = w1; } while (0)
#define RT_CROSS(ACC) do { _Pragma("unroll") for (unsigned hh = 0; hh < 2; ++hh) { bf16x8 tf[8]; _Pragma("unroll") for (unsigned s = 0; s < 8; ++s) tf[s] = trfrag(Timg, hh ? tbase1 : tbase0, s); RT_WAIT(); \
              _Pragma("unroll") for (unsigned s = 0; s < 8; ++s) ACC = RT_MFMA(tf[s], qr[8u * hh + s], ACC); __builtin_amdgcn_sched_barrier(0); \
              RT_LOAD_QH(rbq_, hh); __builtin_amdgcn_sched_barrier(0); } } while (0)
#define RT_FINISH(ACC) do { unsigned lu2_ = lane; asm volatile("" : "+v"(lu2_)); const RT_LAS char* xp = (const RT_LAS char*)lds_u + 133120u + (wid ^ 1u) * 2048u + lane * 32u; \
              const u32x4 w0 = *(const RT_LAS u32x4*)xp, w1 = *(const RT_LAS u32x4*)(xp + 16); \
              _Pragma("unroll") for (int k = 0; k < 4; ++k) { ACC[2 * k] += __builtin_bit_cast(float, w0[k] << 16); ACC[2 * k + 1] += __builtin_bit_cast(float, w0[k] & 0xffff0000u); \
                  ACC[8 + 2 * k] += __builtin_bit_cast(float, w1[k] << 16); ACC[8 + 2 * k + 1] += __builtin_bit_cast(float, w1[k] & 0xffff0000u); } \
              if (!dry || rowfac < 0.f) { unsigned short* yp = (unsigned short*)((char*)(V + (rowbase + 32u * ib) * 4096 + h * 512 + es * 64 + 32u * eb) + ((lu2_ & 31u) * 8192u + (lu2_ >> 5) * 16u)); \
                \
              unsigned gx[4], gy[4]; _Pragma("unroll") for (int g = 0; g < 4; ++g) { gx[g] = cvtpk(ACC[4 * g] * rowfac, ACC[4 * g + 1] * rowfac); gy[g] = cvtpk(ACC[4 * g + 2] * rowfac, ACC[4 * g + 3] * rowfac); } \
              _Pragma("unroll") for (int p = 0; p < 2; ++p) { auto sx = __builtin_amdgcn_permlane32_swap(gx[2 * p], gx[2 * p + 1], false, false); auto sy = __builtin_amdgcn_permlane32_swap(gy[2 * p], gy[2 * p + 1], false, false); \
                  u32x4 w = {sx[0], sy[0], sx[1], sy[1]}; *(u32x4*)(yp + 16 * p) = w; } } } while (0)
            if (eb) { const f32x16 t_ = acc0; acc0 = acc1; acc1 = t_; }
            RT_POST(acc1);
            { const size_t rbn = (c + 1 < nchunk) ? rowbase + 128 : rowbase; RT_LOAD_KV(rbn); }
            const size_t rbq_ = (c + 1 < nchunk) ? rowbase + 128 : rowbase;
            RT_CROSS(acc0);
            __syncthreads();
            RT_FINISH(acc0);
            unsigned lu_ = lane; asm volatile("" : "+v"(lu_));
            const unsigned kbase = trbase(lu_, wid & 3u), v0base = trbase(lu_, 0u), v1base = trbase(lu_, 1u);
#pragma unroll
            for (unsigned g4 = 0; g4 < 4; ++g4) { bf16x8 bk[2], ua[2], ub[2];
#pragma unroll
                for (unsigned k = 0; k < 2; ++k) { bk[k] = trfrag(Kimg + (wid >> 2) * 32768u, kbase, 2u * g4 + k); ua[k] = trfrag(Vimg, v0base, 2u * g4 + k); ub[k] = trfrag(Vimg, v1base, 2u * g4 + k); }
                RT_WAIT();
#pragma unroll
                for (unsigned k = 0; k < 2; ++k) { ST0 = RT_MFMA(ua[k], bk[k], ST0); ST1 = RT_MFMA(ub[k], bk[k], ST1); }
                __builtin_amdgcn_sched_barrier(0); }
            ST0 = ST0 * gC; ST1 = ST1 * gC;
            { const unsigned drow = 32u * (wid & 3u) + r32, chb = 8u * (wid >> 2);
#pragma unroll
              for (unsigned g = 0; g < 4; ++g) { u32x2 w0, w1;
                  w0.x = cvtpk(ST0[4 * g], ST0[4 * g + 1]); w0.y = cvtpk(ST0[4 * g + 2], ST0[4 * g + 3]);
                  w1.x = cvtpk(ST1[4 * g], ST1[4 * g + 1]); w1.y = cvtpk(ST1[4 * g + 2], ST1[4 * g + 3]);
                  *(RT_LAS u32x2*)(Timg + off_b(drow, chb + g) + 8u * hi) = w0;
                  *(RT_LAS u32x2*)(Timg + off_b(drow, chb + 4u + g) + 8u * hi) = w1; } }
        }
    }
}
#undef RT_PK4
#undef RT_POST
#undef RT_CROSS
#undef RT_FINISH
#undef RT_LOAD_KV
#undef RT_LOAD_Q
#undef RT_LOAD_QH
#undef RT_MFMA
#undef RT_WAIT
}
#ifndef MK_ONE_LAUNCH
#define MK_ONE_LAUNCH 1
#endif
constexpr int NB = 4, SEQ = 4096, DM = 2048, NMETA = 16, PADR = 112, LP = 4224, MROWS = NB * LP;
constexpr int RH = 8, RDK = 256, RDV = 512, RVW = 4096, RNIN = 12288;
constexpr int FH = 16, FDH = 128, FNIN = 6160, FNQKV = 6144;
constexpr int NEXP = 32, FFD = 512, MAXSLOT = 40960;
constexpr float RMS_EPS = 1e-6f, GN_EPS = 1e-6f;
constexpr int NWAVES = 8, NTHREADS = 512;

constexpr size_t MiB = 1u << 20;
constexpr size_t WS_CTL = 0, CTL_ZERO_BYTES = 65536;
constexpr size_t WS_TOKE = 1 * MiB, WS_TOKP = WS_TOKE + 256 * 1024, WS_TOKW = WS_TOKP + 256 * 1024, WS_SLOT = WS_TOKW + 256 * 1024;
constexpr size_t WS_CW = 2 * MiB;
constexpr size_t WS_TILEE = 2 * MiB + 512 * 1024;
constexpr size_t WS_LF = 3 * MiB, WS_CC = 5 * MiB, WS_CCS = 6 * MiB + 512 * 1024;
constexpr size_t WS_ROPE = 8 * MiB;
constexpr size_t WS_WRGT = 13 * MiB;
constexpr size_t WS_WRET = 13 * MiB + 128 * 1024;
constexpr size_t WS_WFT = 14 * MiB;
constexpr size_t WS_WRI = 16 * MiB, WS_WRO = 64 * MiB, WS_WFI = 80 * MiB, WS_WFO = 104 * MiB, WS_WGU = 112 * MiB, WS_WDN = 240 * MiB;
constexpr size_t WS_H = 304 * MiB, WS_HN = 436 * MiB, WS_R1 = 502 * MiB, WS_R2 = 700 * MiB;
constexpr int HOLE_MOE0 = 5760, HOLE_MOE1 = 8320;
constexpr int TOKCAP = 16896;
constexpr size_t WS_TOKROW = 964 * MiB, WS_TOKWT = 967 * MiB, WS_END = 970 * MiB;
constexpr size_t ACT_BYTES = (size_t)MROWS * DM * 2;
static_assert(ACT_BYTES == 66 * MiB, "act size");
constexpr int CW_BAR = 4096, CW_CNT = 8192;

#define GAS __attribute__((address_space(1)))
#define LAS __attribute__((address_space(3)))
typedef unsigned short bf16;
typedef unsigned v4u __attribute__((ext_vector_type(4)));
typedef unsigned v2u __attribute__((ext_vector_type(2)));
typedef float f32x4 __attribute__((ext_vector_type(4)));
typedef float f32x2 __attribute__((ext_vector_type(2)));
typedef short bf16x8 __attribute__((ext_vector_type(8)));
typedef _Float16 h16x4 __attribute__((ext_vector_type(4)));
typedef _Float16 h16x8 __attribute__((ext_vector_type(8)));
constexpr int ROUTE_MAXENT = 160;
constexpr int LDS_ROUTE_OFF = 131072 + 2048 + 16384;
constexpr int LDS_WRG_OFF = 131072 + 2048;
#define LDS_WAIT() asm volatile("s_waitcnt lgkmcnt(0)" ::: "memory")
#define VM_WAIT() asm volatile("s_waitcnt vmcnt(0)" ::: "memory")
__device__ __forceinline__ unsigned f2bf(float f) { unsigned u = __builtin_bit_cast(unsigned, f); return (u + 0x7fffu + ((u >> 16) & 1u)) >> 16; }
__device__ __forceinline__ unsigned pk2(float lo, float hi) { unsigned r; asm volatile("v_cvt_pk_bf16_f32 %0, %1, %2" : "=v"(r) : "v"(lo), "v"(hi)); return r; }
__device__ __forceinline__ float bflo(unsigned w) { return __builtin_bit_cast(float, w << 16); }
__device__ __forceinline__ float bfhi(unsigned w) { return __builtin_bit_cast(float, w & 0xffff0000u); }
__device__ __forceinline__ float bf2f(bf16 b) { return __builtin_bit_cast(float, (unsigned)b << 16); }
__device__ __forceinline__ float wave_sum(float v) {
#pragma unroll
    for (int o = 1; o < 64; o <<= 1) v += __shfl_xor(v, o);
    return v;
}

#define XB_TMO      128
#define XB_XCNT(j)  (256  + 64 * (j))
#define XB_XSUB(j)  (1280 + 64 * (j))
#define XB_XGEN(j)  (2304 + 64 * (j))
#define XB_TOP      3328
#define XB_TOPGEN   3392
#define XCD_BAR_WORDS 3456
#define XB_SPIN_CAP (1u << 24)
__device__ __forceinline__ unsigned xb_ld(unsigned* p)              { return __hip_atomic_load(p, __ATOMIC_RELAXED, __HIP_MEMORY_SCOPE_AGENT); }
__device__ __forceinline__ unsigned xb_add(unsigned* p, unsigned v) { return __hip_atomic_fetch_add(p, v, __ATOMIC_RELAXED, __HIP_MEMORY_SCOPE_AGENT); }
__device__ __forceinline__ unsigned xb_xcc_id() { return (unsigned)__builtin_amdgcn_s_getreg((3 << 11) | 20) & 0xFu; }
#define XB_SPIN(cond, bar) do { unsigned _sp = 0; while (cond) { __builtin_amdgcn_s_sleep(1); \
    if ((++_sp & 255u) == 0u) { if (xb_ld(&(bar)[XB_TMO])) break; if (_sp > XB_SPIN_CAP) { atomicAdd(&(bar)[XB_TMO], 1u); break; } } } } while (0)
struct XcdBarrier { unsigned* bar; unsigned x; volatile LAS unsigned* st; int wave; };
__device__ __forceinline__ XcdBarrier xcd_barrier_post(unsigned* bar, volatile LAS unsigned* st, int wave) {
    XcdBarrier b; b.bar = bar; b.x = xb_xcc_id(); b.st = st; b.wave = wave;
    if (wave == 0 && mk_lane_id() == 0) (void)xb_add(&bar[XB_XCNT(b.x)], 1u);
    return b;
}
__device__ __forceinline__ void xcd_barrier_complete(unsigned* bar, unsigned x, unsigned& nloc, unsigned& nx) {
    const unsigned G = gridDim.x * gridDim.y * gridDim.z;
    unsigned sum, cnt, mine, sp = 0u;
    for (;;) {
        sum = 0u; cnt = 0u; mine = 0u;
#pragma unroll
        for (unsigned j = 0; j < 16; ++j) { const unsigned c = xb_ld(&bar[XB_XCNT(j)]); sum += c; cnt += (c > 0u) ? 1u : 0u; mine = (j == x) ? c : mine; }
        if (sum == G) break;
        __builtin_amdgcn_s_sleep(1);
        if ((++sp & 255u) == 0u) { if (xb_ld(&bar[XB_TMO])) break; if (sp > XB_SPIN_CAP) { atomicAdd(&bar[XB_TMO], 1u); break; } }
    }
    nloc = mine > 0u ? mine : 1u; nx = cnt > 0u ? cnt : 1u;
}
__device__ __forceinline__ void xcd_barrier(const XcdBarrier& b) {
    asm volatile("s_waitcnt vmcnt(0)" ::: "memory");
    __syncthreads();
    if (b.wave == 0 && mk_lane_id() == 0) {
        unsigned* bar = b.bar;
        __builtin_amdgcn_s_waitcnt(0);
        unsigned nloc = b.st[0], nx = b.st[1];
        if (nloc == 0u) { xcd_barrier_complete(bar, b.x, nloc, nx); b.st[0] = nloc; b.st[1] = nx; }
        const unsigned old = xb_add(&bar[XB_XSUB(b.x)], 1u);
        const unsigned gen = old / nloc;
        if (old + 1u == (gen + 1u) * nloc) {
            __builtin_amdgcn_fence(__ATOMIC_RELEASE, "agent");
            asm volatile("s_waitcnt vmcnt(0)" ::: "memory");
            const unsigned og = xb_add(&bar[XB_TOP], 1u);
            const unsigned tg = og / nx;
            if (og + 1u == (tg + 1u) * nx) xb_add(&bar[XB_TOPGEN], 1u);
            else XB_SPIN(xb_ld(&bar[XB_TOPGEN]) == tg, bar);
            __builtin_amdgcn_fence(__ATOMIC_ACQUIRE, "agent");
            xb_add(&bar[XB_XGEN(b.x)], 1u);
            asm volatile("s_waitcnt vmcnt(0)" ::: "memory");
        } else {
            XB_SPIN(xb_ld(&bar[XB_XGEN(b.x)]) == gen, bar);
            __builtin_amdgcn_fence(__ATOMIC_ACQUIRE, "agent");
            asm volatile("s_waitcnt vmcnt(0)" ::: "memory");
        }
    }
    __syncthreads();
}

struct Params {
    const float* x; const float* meta; const float* norm_mixer; const float* norm_ffn; const float* norm_final;
    const float* ret_w_in; const float* ret_gn; const float* ret_w_out;
    const float* fox_w_in; const float* fox_b_f; const float* fox_w_out;
    const float* moe_w_rg; const float* moe_b_rg; const float* moe_w_re; const float* moe_b_re;
    const float* moe_w_gate; const float* moe_w_up; const float* moe_w_down;
    float* out; unsigned char* ws; int ph_lo, ph_hi;
};

template <bool NTS = false>
__device__ __forceinline__ void tr_item(const float* W, int ldw, int k0, int n0, bf16* WT, int ldk, int drow0, LAS float* scr, int lane) {
#pragma unroll 4
    for (int i = 0; i < 16; ++i) { const int kk = 4 * i + (lane >> 4), c4 = 4 * (lane & 15);
        const f32x4 v = __builtin_nontemporal_load((const f32x4*)&W[(size_t)(k0 + kk) * ldw + n0 + c4]);
        LAS float* row = scr + kk * 64;
        row[(c4 + 0) ^ kk] = v.x; row[(c4 + 1) ^ kk] = v.y; row[(c4 + 2) ^ kk] = v.z; row[(c4 + 3) ^ kk] = v.w; }
    LDS_WAIT(); asm volatile("" ::: "memory");
    const int c = lane & 7;
#pragma unroll 2
    for (int j = 0; j < 8; ++j) { const int n = (lane >> 3) + 8 * j; float f[8];
#pragma unroll
        for (int e = 0; e < 8; ++e) f[e] = scr[(8 * c + e) * 64 + (n ^ (8 * c + e))];
        v4u o; o.x = pk2(f[0], f[1]); o.y = pk2(f[2], f[3]); o.z = pk2(f[4], f[5]); o.w = pk2(f[6], f[7]);
        if constexpr (NTS) __builtin_nontemporal_store(o, (v4u*)(WT + (size_t)(drow0 + n) * ldk + k0 + 8 * c)); else *(v4u*)(WT + (size_t)(drow0 + n) * ldk + k0 + 8 * c) = o; }
    LDS_WAIT(); asm volatile("" ::: "memory");
}
__device__ __forceinline__ void tr_plain(const float* W, int ldw, int K, int N, bf16* WT, int item, LAS float* scr, int lane) {
    const int nblk = N / 64, kb = item / nblk, nb = item % nblk;
    tr_item(W, ldw, 64 * kb, 64 * nb, WT, K, 64 * nb, scr, lane);
}
__device__ __forceinline__ void tr_moe(const Params& P, int l, int item, LAS float* scr, int lane) {
    bf16* WGU = (bf16*)(P.ws + WS_WGU); bf16* WDN = (bf16*)(P.ws + WS_WDN);
    const int which = item >> 13, r = item & 8191, x = r >> 8, q = r & 255;
    if (which < 2) {
        const float* W = (which == 0 ? P.moe_w_gate : P.moe_w_up) + (size_t)(l * NEXP + x) * DM * FFD;
        const int kb = q >> 3, nb = q & 7, n0 = 64 * nb;
        const int drow0 = (n0 >> 7) * 256 + (n0 & 127) + (which ? 128 : 0);
        tr_item<true>(W, FFD, 64 * kb, n0, WGU + (size_t)x * 1024 * DM, DM, drow0, scr, lane);
    } else {
        const float* W = P.moe_w_down + (size_t)(l * NEXP + x) * FFD * DM;
        const int kb = q >> 5, nb = q & 31;
        tr_item<true>(W, DM, 64 * kb, 64 * nb, WDN + (size_t)x * DM * FFD, FFD, 64 * nb, scr, lane);
    }
}

__device__ __forceinline__ void load_row(const float* row, int lane, f32x4 (&v)[8]) {
#pragma unroll
    for (int j = 0; j < 8; ++j) v[j] = *(const f32x4*)(row + 4 * lane + 256 * j);
}
__device__ __forceinline__ void store_row_f32(float* row, int lane, const f32x4 (&v)[8]) {
#pragma unroll
    for (int j = 0; j < 8; ++j) *(f32x4*)(row + 4 * lane + 256 * j) = v[j];
}
__device__ __forceinline__ void load_row_bf(const bf16* row, int lane, f32x4 (&v)[8]) {
#pragma unroll
    for (int j = 0; j < 8; ++j) { const v2u w = *(const v2u*)(row + 4 * lane + 256 * j); v[j] = (f32x4){bflo(w.x), bfhi(w.x), bflo(w.y), bfhi(w.y)}; }
}
__device__ __forceinline__ void store_row_bf(bf16* row, int lane, const f32x4 (&v)[8]) {
#pragma unroll
    for (int j = 0; j < 8; ++j) { v2u w; w.x = pk2(v[j].x, v[j].y); w.y = pk2(v[j].z, v[j].w); *(v2u*)(row + 4 * lane + 256 * j) = w; }
}
__device__ __forceinline__ void ld8bf(const bf16* p, float (&o)[8]) {
    const v4u w = *(const v4u*)p;
    o[0] = bflo(w.x); o[1] = bfhi(w.x); o[2] = bflo(w.y); o[3] = bfhi(w.y); o[4] = bflo(w.z); o[5] = bfhi(w.z); o[6] = bflo(w.w); o[7] = bfhi(w.w);
}
__device__ __forceinline__ void add_row_bf16(const bf16* row, int lane, f32x4 (&v)[8]) {
#pragma unroll
    for (int j = 0; j < 8; ++j) { const v2u w = __builtin_nontemporal_load((const v2u*)(row + 4 * lane + 256 * j));
        v[j].x += bflo(w.x); v[j].y += bfhi(w.x); v[j].z += bflo(w.y); v[j].w += bfhi(w.y); }
}
__device__ __forceinline__ float rms_gain(f32x4 (&v)[8], const float* gain, int lane) {
    float ss = 0.f;
#pragma unroll
    for (int j = 0; j < 8; ++j) { ss += (v[j].x * v[j].x + v[j].y * v[j].y) + (v[j].z * v[j].z + v[j].w * v[j].w); }
    ss = wave_sum(ss);
    const float rstd = __builtin_amdgcn_rsqf(ss * (1.0f / DM) + RMS_EPS);
#pragma unroll
    for (int j = 0; j < 8; ++j) { const f32x4 g = *(const f32x4*)(gain + 4 * lane + 256 * j); v[j] = v[j] * g; }
    return rstd;
}
__device__ __forceinline__ void store_hn(bf16* row, int lane, const f32x4 (&u)[8], float rstd) {
#pragma unroll
    for (int j = 0; j < 8; ++j) { v2u w; w.x = pk2(u[j].x * rstd, u[j].y * rstd); w.y = pk2(u[j].z * rstd, u[j].w * rstd); *(v2u*)(row + 4 * lane + 256 * j) = w; }
}
__device__ __forceinline__ void zero_hn(bf16* row, int lane) {
#pragma unroll
    for (int j = 0; j < 8; ++j) { v2u w; w.x = 0u; w.y = 0u; *(v2u*)(row + 4 * lane + 256 * j) = w; }
}

__device__ __forceinline__ void phase_prologue(const Params& P, LAS unsigned char* lds, int gw, int NGW, int wave, int lane) {
    asm volatile("" : "+v"(lane)); asm volatile("" : "+s"(gw));
    LAS float* scr = (LAS float*)(lds + wave * 16384);
    bf16* WRI = (bf16*)(P.ws + WS_WRI); bf16* WRO = (bf16*)(P.ws + WS_WRO); bf16* WFI = (bf16*)(P.ws + WS_WFI); bf16* WFO = (bf16*)(P.ws + WS_WFO);
    constexpr int I0 = (DM / 64) * (RNIN / 64), I1 = (RVW / 64) * (DM / 64), I2 = (DM / 64) * (FNQKV / 64), I3 = (DM / 64) * (DM / 64), I4 = 3 * 8192 - HOLE_MOE0;
    constexpr int NIT = I0 + I1 + I2 + I3 + I4;
    _Pragma("nounroll") for (int it = gw; it < NIT; it += NGW) {
        int r = it;
        if (r < I0) { tr_plain(P.ret_w_in, RNIN, DM, RNIN, WRI, r, scr, lane); continue; } r -= I0;
        if (r < I1) { tr_plain(P.ret_w_out, DM, RVW, DM, WRO, r, scr, lane); continue; } r -= I1;
        if (r < I2) { tr_plain(P.fox_w_in, FNIN, DM, FNQKV, WFI, r, scr, lane); continue; } r -= I2;
        if (r < I3) { tr_plain(P.fox_w_out, DM, DM, DM, WFO, r, scr, lane); continue; } r -= I3;
        tr_moe(P, 0, r + HOLE_MOE0, scr, lane);
    }
    { f32x4* WRGT = (f32x4*)(P.ws + WS_WRGT); f32x4* WRET = (f32x4*)(P.ws + WS_WRET); f32x4* WFT = (f32x4*)(P.ws + WS_WFT);
      const int gt = gw * 64 + lane, NGT = NGW * 64;
      _Pragma("nounroll") for (int i = gt; i < 2 * 2048; i += NGT) { const int l = i >> 11, sl = (i >> 6) & 31, ln = i & 63, d = 4 * ln + 256 * (sl >> 2) + (sl & 3);
          const f32x4 w = *(const f32x4*)(P.moe_w_rg + ((size_t)l * DM + d) * 4); h16x4 hv = {(_Float16)w.x, (_Float16)w.y, (_Float16)w.z, (_Float16)w.w};
          ((h16x4*)WRGT)[i] = hv; }
      _Pragma("nounroll") for (int i = gt; i < 2 * 32 * 4 * 64; i += NGT) { const int ln = i & 63, g = (i >> 6) & 3, sl = (i >> 8) & 31, l = i >> 13, d = 4 * ln + 256 * (sl >> 2) + (sl & 3);
          const float* wp = P.moe_w_re + ((size_t)l * DM + d) * 32 + g * 8; const f32x4 w0 = *(const f32x4*)wp, w1 = *(const f32x4*)(wp + 4);
          h16x8 hv = {(_Float16)w0.x, (_Float16)w0.y, (_Float16)w0.z, (_Float16)w0.w, (_Float16)w1.x, (_Float16)w1.y, (_Float16)w1.z, (_Float16)w1.w};
          ((h16x8*)WRET)[i] = hv; }
      _Pragma("nounroll") for (int i = gt; i < 32 * 4 * 64; i += NGT) { const int ln = i & 63, q = (i >> 6) & 3, sl = i >> 8, d = 4 * ln + 256 * (sl >> 2) + (sl & 3);
          WFT[i] = *(const f32x4*)(P.fox_w_in + (size_t)d * FNIN + FNQKV + 4 * q); } }
    bf16* H = (bf16*)(P.ws + WS_H); bf16* HN = (bf16*)(P.ws + WS_HN);
    _Pragma("nounroll") for (int row = gw; row < MROWS; row += NGW) {
        const int b = row / LP, p = row - b * LP;
        bf16* hrow = H + (size_t)row * DM; bf16* nrow = HN + (size_t)row * DM;
        f32x4 v[8];
        if (p < PADR) {
#pragma unroll
            for (int j = 0; j < 8; ++j) v[j] = (f32x4){0.f, 0.f, 0.f, 0.f};
            if (row >= 64 * 256) store_row_bf(hrow, lane, v); zero_hn(nrow, lane); continue; }
        const float* src = (p < PADR + NMETA) ? P.meta + (size_t)(p - PADR) * DM : P.x + ((size_t)b * SEQ + (p - PADR - NMETA)) * DM;
#pragma unroll
        for (int j = 0; j < 8; ++j) v[j] = __builtin_nontemporal_load((const f32x4*)(src + 4 * lane + 256 * j));
        if (row >= 64 * 256) store_row_bf(hrow, lane, v);
        const float rstd = rms_gain(v, P.norm_mixer, lane);
        store_hn(nrow, lane, v, rstd);
    }
}

constexpr int MOE_TAB_OFF = 131072 + 256;
struct MoeTab { LAS int* off; LAS int* cnt; LAS int* tile_e; };
__device__ __forceinline__ MoeTab moe_tab(LAS unsigned char* lds) { MoeTab t; t.off = (LAS int*)(lds + MOE_TAB_OFF); t.cnt = t.off + 64; t.tile_e = t.off + 128; return t; }
__device__ __forceinline__ void moe_tab_build(const Params& P, int l, LAS unsigned char* lds, int wave) {
    const MoeTab T = moe_tab(lds); const unsigned* cnt = (const unsigned*)(P.ws + WS_CTL) + CW_CNT + l * 1024; const int tid = wave * 64 + mk_lane_id();
    __syncthreads();
    if (tid == 0) { int o = 0; for (int e = 0; e < NEXP; ++e) { const int c = (int)cnt[e * 32]; T.off[e] = o; T.cnt[e] = c; o += ((c + 255) >> 8) << 8; } T.off[NEXP] = o; }
    __syncthreads();
    if (tid < 160) { int e = 0; for (int x = 1; x < NEXP; ++x) if (tid * 256 >= T.off[x]) e = x; T.tile_e[tid] = e; }
    __syncthreads();
}
struct EpiRetIn {
    static constexpr bool PERM = true, AFTER_DRAIN = false;
    bf16 *q, *k, *v, *g; const f32x2* rope;
    __device__ __forceinline__ void operator()(const pg8::f32x4 (&acc)[2][2][4][2], const pg8::Unit& u, int wr, int wc, int fr, int fq) const {
        const int row0 = u.pm * 256 + wr * 64 + fr, cc0 = wc * 32 + 8 * fq;
        if (u.pn < 16) {
            bf16* dst = (u.pn < 8 ? q : k) + (size_t)(u.pn & 7) * RDK + cc0;
            const float l2g = u.pn < 8 ? 0.f : __log2f(1.0f - __builtin_amdgcn_exp2f(-5.0f - (float)(u.pn & 7))), sc0 = u.pn < 8 ? 1.0f : 0.0625f;
            float ir[8];
#pragma unroll
            for (int i = 0; i < 8; ++i) ir[i] = __builtin_amdgcn_exp2f((float)(cc0 + i) * (-13.287712379549449f / 128.0f)) * 0.15915494309189535f;
#pragma unroll
            for (int ai = 0; ai < 2; ++ai)
#pragma unroll
                for (int m = 0; m < 4; ++m) {
                    const int row = row0 + ai * 128 + m * 16; const int p = row % LP; const float pf = (float)(p - PADR); const float sc = sc0 * __builtin_amdgcn_exp2f((float)(127 - (p & 127)) * l2g);
                    float cs[8], sn[8];
#pragma unroll
                    for (int i = 0; i < 8; ++i) { const float fr = __builtin_amdgcn_fractf(pf * ir[i]); cs[i] = __builtin_amdgcn_cosf(fr); sn[i] = __builtin_amdgcn_sinf(fr); }
                    float o1[8], o2[8];
#pragma unroll
                    for (int n = 0; n < 2; ++n)
#pragma unroll
                        for (int e = 0; e < 4; ++e) { const float u1 = acc[ai][0][m][n][e], u2 = acc[ai][1][m][n][e]; const int i = 4 * n + e;
                            o1[i] = (u1 * cs[i] - u2 * sn[i]) * sc; o2[i] = (u1 * sn[i] + u2 * cs[i]) * sc; }
                    v4u w1, w2;
                    w1.x = pg8::cvt_pk_bf16(o1[0], o1[1]); w1.y = pg8::cvt_pk_bf16(o1[2], o1[3]); w1.z = pg8::cvt_pk_bf16(o1[4], o1[5]); w1.w = pg8::cvt_pk_bf16(o1[6], o1[7]);
                    w2.x = pg8::cvt_pk_bf16(o2[0], o2[1]); w2.y = pg8::cvt_pk_bf16(o2[2], o2[3]); w2.z = pg8::cvt_pk_bf16(o2[4], o2[5]); w2.w = pg8::cvt_pk_bf16(o2[6], o2[7]);
                    if (u.pn < 8) {
                        const int c1 = cc0 >> 3; bf16* qb = q + (((size_t)(row >> 5) * 8 + u.pn) * 16) * 512 + (row & 31) * 8;
                        *(v4u*)(qb + (c1 >> 1) * 512 + (c1 & 1) * 256) = w1; *(v4u*)(qb + (8 + (c1 >> 1)) * 512 + (c1 & 1) * 256) = w2; }
                    else { bf16* rowp = dst + (size_t)row * DM; *(v4u*)rowp = w1; *(v4u*)(rowp + 128) = w2; }
                }
        } else {
            bf16* dst = (u.pn < 32 ? v + (size_t)(u.pn - 16) * 256 : g + (size_t)(u.pn - 32) * 256) + cc0;
#pragma unroll
            for (int ai = 0; ai < 2; ++ai)
#pragma unroll
                for (int m = 0; m < 4; ++m) { bf16* rowp = dst + (size_t)(row0 + ai * 128 + m * 16) * RVW;
#pragma unroll
                    for (int bj = 0; bj < 2; ++bj) { const pg8::f32x4 v0 = acc[ai][bj][m][0], v1 = acc[ai][bj][m][1]; v4u w;
                        w.x = pg8::cvt_pk_bf16(v0[0], v0[1]); w.y = pg8::cvt_pk_bf16(v0[2], v0[3]); w.z = pg8::cvt_pk_bf16(v1[0], v1[1]); w.w = pg8::cvt_pk_bf16(v1[2], v1[3]);
                        *(v4u*)(rowp + bj * 128) = w; } }
        }
    }
};
template <bool FROMX>
struct EpiResidT {
    static constexpr bool PERM = true, AFTER_DRAIN = false;
    bf16* H; int dry; const float* x; const float* meta;
    __device__ __forceinline__ void operator()(const pg8::f32x4 (&acc)[2][2][4][2], const pg8::Unit& u, int wr, int wc, int fr, int fq) const {
        const int row0 = u.pm * 256 + wr * 64 + fr, col0 = u.pn * 256 + wc * 32 + 8 * fq;
        if (dry && acc[0][0][0][0][0] != 12345.678f) return;
#pragma unroll
        for (int ai = 0; ai < 2; ++ai)
#pragma unroll
            for (int m = 0; m < 4; ++m) { bf16* rowp = H + (size_t)(row0 + ai * 128 + m * 16) * DM + col0;
                if constexpr (FROMX) { const int row = row0 + ai * 128 + m * 16, b = row / LP, pp = row - b * LP;
                    const float* src = pp < PADR + NMETA ? meta + (size_t)(pp < PADR ? 0 : pp - PADR) * DM : x + ((size_t)b * SEQ + (pp - PADR - NMETA)) * DM; const float keep = pp < PADR ? 0.f : 1.f;
#pragma unroll
                    for (int bj = 0; bj < 2; ++bj) { const pg8::f32x4 a0 = *(const pg8::f32x4*)(src + col0 + bj * 128), a1 = *(const pg8::f32x4*)(src + col0 + bj * 128 + 4); const pg8::f32x4 v0 = acc[ai][bj][m][0], v1 = acc[ai][bj][m][1]; v4u w;
                        w.x = pg8::cvt_pk_bf16(a0[0] * keep + v0[0], a0[1] * keep + v0[1]); w.y = pg8::cvt_pk_bf16(a0[2] * keep + v0[2], a0[3] * keep + v0[3]);
                        w.z = pg8::cvt_pk_bf16(a1[0] * keep + v1[0], a1[1] * keep + v1[1]); w.w = pg8::cvt_pk_bf16(a1[2] * keep + v1[2], a1[3] * keep + v1[3]);
                        *(v4u*)(rowp + bj * 128) = w; } }
                else {
#pragma unroll
                for (int bj = 0; bj < 2; ++bj) { v4u* p = (v4u*)(rowp + bj * 128); const v4u h = *p; const pg8::f32x4 v0 = acc[ai][bj][m][0], v1 = acc[ai][bj][m][1]; v4u w;
                    w.x = pg8::cvt_pk_bf16(bflo(h.x) + v0[0], bfhi(h.x) + v0[1]); w.y = pg8::cvt_pk_bf16(bflo(h.y) + v0[2], bfhi(h.y) + v0[3]);
                    w.z = pg8::cvt_pk_bf16(bflo(h.z) + v1[0], bfhi(h.z) + v1[1]); w.w = pg8::cvt_pk_bf16(bflo(h.w) + v1[2], bfhi(h.w) + v1[3]);
                    *p = w; } } }
    }
};
constexpr int LEFT_ROW0 = 64 * 256, LEFT_ROWS = MROWS - LEFT_ROW0;
struct EpiSlab {
    static constexpr bool PERM = false, AFTER_DRAIN = false;
    float* slab; int klen;
    __device__ __forceinline__ void operator()(const pg8::f32x4 (&acc)[2][2][4][2], const pg8::Unit& u, int wr, int wc, int fr, int fq) const {
        const int row0 = (u.pm - 64) * 256 + wr * 64 + fr, col0 = u.pn * 256 + wc * 32 + 4 * fq; float* base = slab + (size_t)(u.ko / klen) * LEFT_ROWS * DM;
#pragma unroll
        for (int ai = 0; ai < 2; ++ai)
#pragma unroll
            for (int m = 0; m < 4; ++m) { float* rowp = base + (size_t)(row0 + ai * 128 + m * 16) * DM + col0;
#pragma unroll
                for (int bj = 0; bj < 2; ++bj)
#pragma unroll
                    for (int n = 0; n < 2; ++n) *(pg8::f32x4*)(rowp + bj * 128 + n * 16) = acc[ai][bj][m][n]; }
    }
};
struct SplitKOrder {
    int pm0, npm, nN, KS, klen, G, c;
    __device__ __forceinline__ bool next(int i, pg8::Unit& u) const {
        const int L = i * G + c; if (L >= npm * nN * KS) return false;
        const int ks = L % KS, t = L / KS; u.pn = t % nN; u.pm = pm0 + t / nN; u.ko = ks * klen; return true;
    }
    __device__ __forceinline__ void a_ready(const pg8::Unit&) const {}
    __device__ __forceinline__ void done(const pg8::Unit&) const {}
};
struct EpiGateUp {
    static constexpr bool PERM = true, AFTER_DRAIN = false;
    bf16* hid; const float* tokwt; MoeTab T;
    __device__ __forceinline__ void operator()(const pg8::f32x4 (&acc)[2][2][4][2], const pg8::Unit& u, int wr, int wc, int fr, int fq) const {
        const int row0 = u.pm * 256 + wr * 64 + fr, col0 = (u.pn & 3) * 128 + wc * 32 + 8 * fq;
#pragma unroll
        for (int ai = 0; ai < 2; ++ai)
#pragma unroll
            for (int m = 0; m < 4; ++m) { const int row = row0 + ai * 128 + m * 16; const int e_ = T.tile_e[u.pm], pos_ = row - T.off[e_]; const float c = pos_ < T.cnt[e_] ? tokwt[e_ * TOKCAP + pos_] : 0.f; float o[8];
#pragma unroll
                for (int n = 0; n < 2; ++n)
#pragma unroll
                    for (int e = 0; e < 4; ++e) { const float a = acc[ai][0][m][n][e], up = acc[ai][1][m][n][e];
                        o[4 * n + e] = a * __builtin_amdgcn_rcpf(1.0f + __expf(-a)) * up * c; }
                v4u w; w.x = pg8::cvt_pk_bf16(o[0], o[1]); w.y = pg8::cvt_pk_bf16(o[2], o[3]); w.z = pg8::cvt_pk_bf16(o[4], o[5]); w.w = pg8::cvt_pk_bf16(o[6], o[7]);
                *(v4u*)(hid + (size_t)row * FFD + col0) = w; }
    }
};
struct EpiDown {
    static constexpr bool PERM = true, AFTER_DRAIN = false;
    bf16* y;
    __device__ __forceinline__ void operator()(const pg8::f32x4 (&acc)[2][2][4][2], const pg8::Unit& u, int wr, int wc, int fr, int fq) const {
        const int row0 = u.pm * 256 + wr * 64 + fr, col0 = (u.pn & 7) * 256 + wc * 32 + 8 * fq;
#pragma unroll
        for (int ai = 0; ai < 2; ++ai)
#pragma unroll
            for (int m = 0; m < 4; ++m) { bf16* rowp = y + (size_t)(row0 + ai * 128 + m * 16) * DM + col0;
#pragma unroll
                for (int bj = 0; bj < 2; ++bj) { const pg8::f32x4 v0 = acc[ai][bj][m][0], v1 = acc[ai][bj][m][1]; v4u w;
                    w.x = pg8::cvt_pk_bf16(v0[0], v0[1]); w.y = pg8::cvt_pk_bf16(v0[2], v0[3]); w.z = pg8::cvt_pk_bf16(v1[0], v1[1]); w.w = pg8::cvt_pk_bf16(v1[2], v1[3]);
                    *(v4u*)(rowp + bj * 128) = w; } }
    }
};
struct GroupSched {
    MoeTab T; const int* tokrow; int TM, NT, G, c;
    __device__ __forceinline__ void init(const MoeTab& t, const int* tr, int nt, int G_, int c_) { T = t; tokrow = tr; TM = t.off[NEXP] >> 8; NT = nt; G = G_; c = c_; }
    __device__ __forceinline__ bool next(int i, pg8::Unit& u) const {
        if (G & 7) { const int L = i * G + c; const int mt = L / NT, nt = L % NT; if (mt >= TM) return false; u.pm = mt; u.pn = T.tile_e[mt] * NT + nt; u.ko = 0; return true; }
        const int cls = c & 7; int j = i * (G >> 3) + (c >> 3);
#pragma unroll
        for (int q = 0; q < 4; ++q) { const int e = cls + 8 * q, m0 = T.off[e] >> 8, n = ((T.off[e + 1] >> 8) - m0) * NT;
            if (j < n) { u.pm = m0 + j / NT; u.pn = e * NT + j % NT; u.ko = 0; return true; }
            j -= n; }
        return false;
    }
    __device__ __forceinline__ int arow(const pg8::Unit& u, int r) const { const int e = T.tile_e[u.pm], pos = u.pm * 256 - T.off[e] + r; return pos < T.cnt[e] ? tokrow[e * TOKCAP + pos] : 0; }
    __device__ __forceinline__ void a_ready(const pg8::Unit&) const {}
    __device__ __forceinline__ void done(const pg8::Unit&) const {}
};

__device__ __forceinline__ void phase_gn_gate(const Params& P, int gw, int NGW, int lane, bool dry = false) {
    asm volatile("" : "+v"(lane)); asm volatile("" : "+s"(gw));
    const bf16* Y = (const bf16*)(P.ws + WS_R2); bf16* G = (bf16*)(P.ws + WS_R2 + 2 * ACT_BYTES);
    constexpr int NIT = MROWS * RH, U = 4;
    _Pragma("nounroll") for (int it0 = gw; it0 < NIT; it0 += NGW * U) {
        v4u yw[U], gw4[U]; size_t off[U];
#pragma unroll
        for (int k = 0; k < U; ++k) { int it = it0 + k * NGW; if (it >= NIT) it = it0; const int row = it >> 3, h = it & 7; off[k] = (size_t)row * RVW + h * RDV + lane * 8;
            yw[k] = __builtin_nontemporal_load((const v4u*)(Y + off[k])); gw4[k] = __builtin_nontemporal_load((const v4u*)(G + off[k])); }
#pragma unroll
        for (int k = 0; k < U; ++k) { const int it = it0 + k * NGW; const int h = it & 7;
            float y[8], g[8];
            y[0] = bflo(yw[k].x); y[1] = bfhi(yw[k].x); y[2] = bflo(yw[k].y); y[3] = bfhi(yw[k].y); y[4] = bflo(yw[k].z); y[5] = bfhi(yw[k].z); y[6] = bflo(yw[k].w); y[7] = bfhi(yw[k].w);
            g[0] = bflo(gw4[k].x); g[1] = bfhi(gw4[k].x); g[2] = bflo(gw4[k].y); g[3] = bfhi(gw4[k].y); g[4] = bflo(gw4[k].z); g[5] = bfhi(gw4[k].z); g[6] = bflo(gw4[k].w); g[7] = bfhi(gw4[k].w);
            float s = 0.f;
#pragma unroll
            for (int i = 0; i < 8; ++i) s += y[i];
            const float mu = wave_sum(s) * (1.0f / RDV); float q = 0.f;
#pragma unroll
            for (int i = 0; i < 8; ++i) { y[i] -= mu; q += y[i] * y[i]; }
            const float rstd = __builtin_amdgcn_rsqf(wave_sum(q) * (1.0f / RDV) + GN_EPS);
            const float* gn = P.ret_gn + h * RDV + lane * 8; float o[8];
#pragma unroll
            for (int i = 0; i < 8; ++i) { const float sg = g[i] * __builtin_amdgcn_rcpf(1.0f + __expf(-g[i])); o[i] = sg * (y[i] * rstd * gn[i]); }
            v4u w; w.x = pk2(o[0], o[1]); w.y = pk2(o[2], o[3]); w.z = pk2(o[4], o[5]); w.w = pk2(o[6], o[7]);
            if (it < NIT && (!dry || rstd < 0.f)) *(v4u*)(G + off[k]) = w; }
    }
}

__device__ __forceinline__ void route_row(const Params& P, int l, int row, const f32x4 (&u)[8], float rstd, int lane, int slot, LAS unsigned char* lds) {
    float lg[4] = {0.f, 0.f, 0.f, 0.f};
    unsigned wo = (unsigned)lane; asm volatile("" : "+v"(wo)); const LAS h16x4* wl = (const LAS h16x4*)(lds + LDS_WRG_OFF) + wo;
#pragma unroll
    for (int j = 0; j < 8; ++j) {
#pragma unroll
        for (int i = 0; i < 4; ++i) { const h16x4 w = wl[(j * 4 + i) * 64]; const float x = u[j][i];
            lg[0] += x * (float)w[0]; lg[1] += x * (float)w[1]; lg[2] += x * (float)w[2]; lg[3] += x * (float)w[3]; } }
    {
      float a2[2], w;
#pragma unroll
      for (int k = 0; k < 2; ++k) { const bool up = (lane & 32) != 0; const float snd = up ? lg[2 * k] : lg[2 * k + 1]; a2[k] = (up ? lg[2 * k + 1] : lg[2 * k]) + __shfl_xor(snd, 32); }
      { const bool up = (lane & 16) != 0; const float snd = up ? a2[0] : a2[1]; w = (up ? a2[1] : a2[0]) + __shfl_xor(snd, 16); }
      w += __shfl_xor(w, 8); w += __shfl_xor(w, 4); w += __shfl_xor(w, 2); w += __shfl_xor(w, 1);
      const int wi = __builtin_bit_cast(int, w);
      lg[0] = __builtin_bit_cast(float, __builtin_amdgcn_readlane(wi, 0)); lg[1] = __builtin_bit_cast(float, __builtin_amdgcn_readlane(wi, 32));
      lg[2] = __builtin_bit_cast(float, __builtin_amdgcn_readlane(wi, 16)); lg[3] = __builtin_bit_cast(float, __builtin_amdgcn_readlane(wi, 48)); }
#pragma unroll
    for (int g = 0; g < 4; ++g) lg[g] = lg[g] * rstd + P.moe_b_rg[l * 4 + g];
    int gs = 0; float gm = lg[0];
#pragma unroll
    for (int g = 1; g < 4; ++g) if (lg[g] > gm) { gm = lg[g]; gs = g; }
    float den = 0.f;
#pragma unroll
    for (int g = 0; g < 4; ++g) den += __expf(lg[g] - gm);
    const float pg = __builtin_amdgcn_rcpf(den);
    float le[8] = {0.f, 0.f, 0.f, 0.f, 0.f, 0.f, 0.f, 0.f};
    unsigned wo2 = (unsigned)lane + (unsigned)gs * 64u; asm volatile("" : "+v"(wo2)); const LAS h16x8* wl2 = (const LAS h16x8*)lds + wo2;
#pragma unroll
    for (int j = 0; j < 8; ++j) {
#pragma unroll
        for (int i = 0; i < 4; ++i) { const h16x8 w = wl2[(j * 4 + i) * 256]; const float x = u[j][i];
#pragma unroll
            for (int e = 0; e < 8; ++e) le[e] += x * (float)w[e]; } }
    {
      float a4[4], a2[2], w;
#pragma unroll
      for (int k = 0; k < 4; ++k) { const bool up = (lane & 32) != 0; const float snd = up ? le[2 * k] : le[2 * k + 1]; a4[k] = (up ? le[2 * k + 1] : le[2 * k]) + __shfl_xor(snd, 32); }
#pragma unroll
      for (int k = 0; k < 2; ++k) { const bool up = (lane & 16) != 0; const float snd = up ? a4[2 * k] : a4[2 * k + 1]; a2[k] = (up ? a4[2 * k + 1] : a4[2 * k]) + __shfl_xor(snd, 16); }
      { const bool up = (lane & 8) != 0; const float snd = up ? a2[0] : a2[1]; w = (up ? a2[1] : a2[0]) + __shfl_xor(snd, 8); }
      w += __shfl_xor(w, 4); w += __shfl_xor(w, 2); w += __shfl_xor(w, 1);
      const int wi = __builtin_bit_cast(int, w);
#pragma unroll
      for (int e = 0; e < 8; ++e) le[e] = __builtin_bit_cast(float, __builtin_amdgcn_readlane(wi, 32 * (e & 1) + 16 * ((e >> 1) & 1) + 8 * ((e >> 2) & 1))); }
#pragma unroll
    for (int e = 0; e < 8; ++e) le[e] = le[e] * rstd + P.moe_b_re[l * 32 + gs * 8 + e];
    int i1 = 0; float m1 = le[0];
#pragma unroll
    for (int e = 1; e < 8; ++e) if (le[e] > m1) { m1 = le[e]; i1 = e; }
    int i2 = -1; float m2 = -3.0e38f;
#pragma unroll
    for (int e = 0; e < 8; ++e) if (e != i1 && le[e] > m2) { m2 = le[e]; i2 = e; }
    const float r = __expf(m2 - m1), w1 = __builtin_amdgcn_rcpf(1.0f + r), w2 = r * w1;
    if (lane == 0) {
        LAS int* rl = (LAS int*)(lds + LDS_ROUTE_OFF); const int e1 = gs * 8 + i1, e2 = gs * 8 + i2;
        const int k = __hip_atomic_fetch_add(rl + 64, 1, __ATOMIC_RELAXED, __HIP_MEMORY_SCOPE_WORKGROUP);
        if (k < ROUTE_MAXENT) {
            const int r1 = __hip_atomic_fetch_add(rl + e1, 1, __ATOMIC_RELAXED, __HIP_MEMORY_SCOPE_WORKGROUP), r2 = __hip_atomic_fetch_add(rl + e2, 1, __ATOMIC_RELAXED, __HIP_MEMORY_SCOPE_WORKGROUP);
            LAS int* en = rl + 80 + 8 * k; en[0] = row; en[1] = e1; en[2] = e2; en[3] = r1; en[4] = r2; ((LAS float*)en)[5] = pg * w1; ((LAS float*)en)[6] = pg * w2;
        } else {
            unsigned* cnt = (unsigned*)(P.ws + WS_CTL) + CW_CNT + slot * 1024; const int p1 = (int)atomicAdd(cnt + e1 * 32, 1u), p2 = (int)atomicAdd(cnt + e2 * 32, 1u);
            int* tok_e = (int*)(P.ws + WS_TOKE); int* tok_p = (int*)(P.ws + WS_TOKP); int* tokrow = (int*)(P.ws + WS_TOKROW); float* tokwt = (float*)(P.ws + WS_TOKWT);
            tok_e[row * 2] = e1; tok_e[row * 2 + 1] = e2; tok_p[row * 2] = p1; tok_p[row * 2 + 1] = p2;
            tokrow[e1 * TOKCAP + p1] = row; tokrow[e2 * TOKCAP + p2] = row; tokwt[e1 * TOKCAP + p1] = pg * w1; tokwt[e2 * TOKCAP + p2] = pg * w2; }
    }
}
__device__ __forceinline__ void route_flush(const Params& P, int slot, LAS unsigned char* lds, int tid) {
    LAS int* rl = (LAS int*)(lds + LDS_ROUTE_OFF);
    __syncthreads();
    if (tid < NEXP) { const int c = rl[tid]; unsigned* cnt = (unsigned*)(P.ws + WS_CTL) + CW_CNT + slot * 1024 + tid * 32; rl[32 + tid] = c ? (int)atomicAdd(cnt, (unsigned)c) : 0; }
    __syncthreads();
    const int nent = rl[64] < ROUTE_MAXENT ? rl[64] : ROUTE_MAXENT;
    if (tid < 2 * nent) { const LAS int* en = rl + 80 + 8 * (tid >> 1); const int j = tid & 1, row = en[0], e = en[1 + j], pos = rl[32 + e] + en[3 + j]; const float w = ((const LAS float*)en)[5 + j];
        int* tok_e = (int*)(P.ws + WS_TOKE); int* tok_p = (int*)(P.ws + WS_TOKP); int* tokrow = (int*)(P.ws + WS_TOKROW); float* tokwt = (float*)(P.ws + WS_TOKWT);
        tok_e[row * 2 + j] = e; tok_p[row * 2 + j] = pos; tokrow[e * TOKCAP + pos] = row; tokwt[e * TOKCAP + pos] = w; }
}
__device__ __forceinline__ void phase_norm_route(const Params& P, int l, int gw, int NGW, int lane, int slot, int nslab, LAS unsigned char* lds, int wave) {
    asm volatile("" : "+v"(lane)); asm volatile("" : "+s"(gw));
    __syncthreads();
    if (wave == 0) { LAS int* rl = (LAS int*)(lds + LDS_ROUTE_OFF); rl[lane] = 0; if (lane == 0) rl[64] = 0; }
    { const v4u* src = (const v4u*)(P.ws + WS_WRET) + (size_t)l * 8192; LAS v4u* dst = (LAS v4u*)lds; const int t0 = wave * 64 + lane;
#pragma unroll
      for (int i = 0; i < 16; ++i) dst[t0 + 512 * i] = src[t0 + 512 * i];
      const v4u* s2 = (const v4u*)(P.ws + WS_WRGT) + (size_t)l * 1024; LAS v4u* d2 = (LAS v4u*)(lds + LDS_WRG_OFF);
#pragma unroll
      for (int i = 0; i < 2; ++i) d2[t0 + 512 * i] = s2[t0 + 512 * i]; }
    __syncthreads();
    const bf16* H = (const bf16*)(P.ws + WS_H); bf16* HN = (bf16*)(P.ws + WS_HN);
    _Pragma("nounroll") for (int row = gw; row < MROWS; row += NGW) {
        const int p = row % LP; bf16* nrow = HN + (size_t)row * DM;
        if (p < PADR) { zero_hn(nrow, lane); continue; }
        f32x4 v[8]; load_row_bf(H + (size_t)row * DM, lane, v);
        if (row >= LEFT_ROW0 && nslab > 0) {
            const float* sl = (const float*)(P.ws + WS_R1 + 2 * ACT_BYTES) + (size_t)(row - LEFT_ROW0) * DM;
            _Pragma("nounroll") for (int k = 0; k < nslab; ++k) { f32x4 t[8]; load_row(sl + (size_t)k * LEFT_ROWS * DM, lane, t);
#pragma unroll
                for (int j = 0; j < 8; ++j) v[j] = v[j] + t[j]; }
            store_row_bf((bf16*)(P.ws + WS_H) + (size_t)row * DM, lane, v); }
        const float rstd = rms_gain(v, P.norm_ffn + (size_t)l * DM, lane);
        store_hn(nrow, lane, v, rstd);
        route_row(P, l, row, v, rstd, lane, slot, lds);
    }
    route_flush(P, slot, lds, wave * 64 + lane);
}
__device__ __forceinline__ void phase_l1_entry(const Params& P, LAS unsigned char* lds, int gw, int NGW, int wave, int lane, bool dry = false) {
    asm volatile("" : "+v"(lane)); asm volatile("" : "+s"(gw));
    LAS float* scr = (LAS float*)(lds + wave * 16384);
    _Pragma("nounroll") for (int it = HOLE_MOE1 + gw; it < 3 * 8192; it += NGW) tr_moe(P, 1, it, scr, lane);
    __syncthreads();
    { const f32x4* src = (const f32x4*)(P.ws + WS_WFT); LAS f32x4* dst = (LAS f32x4*)lds; const int t0 = wave * 64 + lane;
#pragma unroll
      for (int i = 0; i < 16; ++i) dst[t0 + 512 * i] = src[t0 + 512 * i]; }
    __syncthreads();
    bf16* H = (bf16*)(P.ws + WS_H); bf16* HN = (bf16*)(P.ws + WS_HN); const bf16* Y = (const bf16*)(P.ws + WS_R2);
    const int* tok_e = (const int*)(P.ws + WS_TOKE); const int* tok_p = (const int*)(P.ws + WS_TOKP); const MoeTab T = moe_tab(lds); float* LF = (float*)(P.ws + WS_LF);
    _Pragma("nounroll") for (int row = gw; row < MROWS; row += NGW) {
        const int b = row / LP, p = row - b * LP; bf16* nrow = HN + (size_t)row * DM;
        if (p < PADR) { zero_hn(nrow, lane); if (lane < FH) LF[((size_t)b * FH + lane) * LP + p] = 0.f; continue; }
        f32x4 v[8]; bf16* hrow = H + (size_t)row * DM; load_row_bf(hrow, lane, v);
        { const int s0 = T.off[tok_e[row * 2]] + tok_p[row * 2], s1 = T.off[tok_e[row * 2 + 1]] + tok_p[row * 2 + 1];
          add_row_bf16(Y + (size_t)s0 * DM, lane, v); add_row_bf16(Y + (size_t)s1 * DM, lane, v); }
        if (!dry || v[0].x == 1.2345e30f) store_row_bf(hrow, lane, v);
        const float rstd = rms_gain(v, P.norm_mixer + DM, lane);
        if (!dry || rstd < 0.f) store_hn(nrow, lane, v, rstd);
        float f[16];
#pragma unroll
        for (int j = 0; j < 16; ++j) f[j] = 0.f;
        unsigned wfo = (unsigned)lane; asm volatile("" : "+v"(wfo)); const LAS f32x4* wf = (const LAS f32x4*)lds + wfo;
#pragma unroll
        for (int jj = 0; jj < 8; ++jj) {
#pragma unroll
            for (int i = 0; i < 4; ++i) { const LAS f32x4* wp = wf + (jj * 4 + i) * 256; const float x = v[jj][i];
#pragma unroll
                for (int q = 0; q < 4; ++q) { const f32x4 w = wp[64 * q]; f[4 * q] += x * w.x; f[4 * q + 1] += x * w.y; f[4 * q + 2] += x * w.z; f[4 * q + 3] += x * w.w; } } }
        float g8[8], g4[4], g2[2], w1;
#pragma unroll
        for (int k = 0; k < 8; ++k) { const bool up = (lane & 32) != 0; const float snd = up ? f[2 * k] : f[2 * k + 1]; g8[k] = (up ? f[2 * k + 1] : f[2 * k]) + __shfl_xor(snd, 32); }
#pragma unroll
        for (int k = 0; k < 4; ++k) { const bool up = (lane & 16) != 0; const float snd = up ? g8[2 * k] : g8[2 * k + 1]; g4[k] = (up ? g8[2 * k + 1] : g8[2 * k]) + __shfl_xor(snd, 16); }
#pragma unroll
        for (int k = 0; k < 2; ++k) { const bool up = (lane & 8) != 0; const float snd = up ? g4[2 * k] : g4[2 * k + 1]; g2[k] = (up ? g4[2 * k + 1] : g4[2 * k]) + __shfl_xor(snd, 8); }
        { const bool up = (lane & 4) != 0; const float snd = up ? g2[0] : g2[1]; w1 = (up ? g2[1] : g2[0]) + __shfl_xor(snd, 4); }
        w1 += __shfl_xor(w1, 1); w1 += __shfl_xor(w1, 2);
        const int hd = 8 * ((lane >> 2) & 1) + 4 * ((lane >> 3) & 1) + 2 * ((lane >> 4) & 1) + ((lane >> 5) & 1);
        if ((lane & 3) == 0 && (!dry || rstd < 0.f)) { const float xx = w1 * rstd + P.fox_b_f[hd];
            const float ls = fminf(xx, 0.f) - log1pf(__expf(-fabsf(xx)));
            LF[((size_t)b * FH + hd) * LP + p] = ls; }
    }
}
__device__ __forceinline__ void phase_cumsum(const Params& P, int gw, int NGW, int lane, LAS unsigned char* lds) {
    asm volatile("" : "+v"(lane)); asm volatile("" : "+s"(gw));
    const float* LF = (const float*)(P.ws + WS_LF); float* CC = (float*)(P.ws + WS_CC); float* CCS = (float*)(P.ws + WS_CCS);
    LAS float* L = (LAS float*)(lds + LDS_WRG_OFF);
    _Pragma("nounroll") for (int sq = gw; sq < NB * FH; sq += NGW) {
        const float* src = LF + (size_t)sq * LP; float* dst = CC + (size_t)sq * LP; float* dsc = CCS + (size_t)sq * LP;
#pragma unroll
        for (int i = 0; i < 66; ++i) L[i * 64 + lane] = src[i * 64 + lane];
        asm volatile("s_waitcnt lgkmcnt(0)" ::: "memory");
        float v[66]; float t = 0.f;
#pragma unroll
        for (int i = 0; i < 66; ++i) { t += L[lane * 66 + i]; v[i] = t; }
        float inc = t;
#pragma unroll
        for (int o = 1; o < 64; o <<= 1) { const float n = __shfl_up(inc, o); if (lane >= o) inc += n; }
        const float base = inc - t;
        asm volatile("s_waitcnt lgkmcnt(0)" ::: "memory");
#pragma unroll
        for (int i = 0; i < 66; ++i) L[lane * 66 + i] = v[i] + base;
        asm volatile("s_waitcnt lgkmcnt(0)" ::: "memory");
#pragma unroll
        for (int i = 0; i < 66; ++i) { const float c = L[i * 64 + lane]; dst[i * 64 + lane] = c; dsc[i * 64 + lane] = c * -11.313708498984761f;   }
        asm volatile("s_waitcnt lgkmcnt(0)" ::: "memory");
    }
}
__device__ __forceinline__ void phase_attn_simple(const Params& P, LAS unsigned char* lds, int wave) {
    const bf16* Q = (const bf16*)(P.ws + WS_R1); const bf16* K = (const bf16*)(P.ws + WS_R1 + ACT_BYTES); const bf16* V = (const bf16*)(P.ws + WS_R1 + 2 * ACT_BYTES);
    bf16* O = (bf16*)(P.ws + WS_R2); const float* CC = (const float*)(P.ws + WS_CC);
    constexpr int LD = 132;
    LAS float* Qs = (LAS float*)lds; LAS float* Ks = Qs + 64 * LD; LAS float* Vs = Ks + 64 * LD; LAS float* Ss = Vs + 64 * LD; LAS float* cks = Ss + 64 * 65;
    const int r = mk_lane_id(), w = wave, tid = w * 64 + r;
    const float scale = 0.08838834764831845f;
    _Pragma("nounroll") for (int unit = blockIdx.x; unit < NB * FH * 66; unit += gridDim.x) {
        const int qb = unit % 66, bh = unit / 66, b = bh / FH, hd = bh % FH;
        if (qb != 1) continue;
        const int q0 = qb * 64; const size_t rbase = (size_t)b * LP;
        __syncthreads();
        { const int rr = tid >> 3, ch = tid & 7;
#pragma unroll
          for (int i = 0; i < 2; ++i) { float f[8]; ld8bf(Q + (rbase + q0 + rr) * DM + hd * FDH + (ch * 2 + i) * 8, f);
#pragma unroll
              for (int j = 0; j < 8; ++j) Qs[rr * LD + (ch * 2 + i) * 8 + j] = f[j]; } }
        const float cq = CC[((size_t)b * FH + hd) * LP + q0 + r]; const int pq = q0 + r;
        float m_run = -1e30f, l_run = 0.f, o[16];
#pragma unroll
        for (int i = 0; i < 16; ++i) o[i] = 0.f;
        _Pragma("nounroll") for (int kt = 1; kt <= qb; ++kt) {
            const int k0 = kt * 64;
            __syncthreads();
            { const int rr = tid >> 3, ch = tid & 7;
#pragma unroll
              for (int i = 0; i < 2; ++i) { float f[8]; ld8bf(K + (rbase + k0 + rr) * DM + hd * FDH + (ch * 2 + i) * 8, f);
#pragma unroll
                  for (int j = 0; j < 8; ++j) Ks[rr * LD + (ch * 2 + i) * 8 + j] = f[j];
                  ld8bf(V + (rbase + k0 + rr) * DM + hd * FDH + (ch * 2 + i) * 8, f);
#pragma unroll
                  for (int j = 0; j < 8; ++j) Vs[rr * LD + (ch * 2 + i) * 8 + j] = f[j]; }
              if (tid < 64) cks[tid] = CC[((size_t)b * FH + hd) * LP + k0 + tid]; }
            __syncthreads();
            { float s[8];
#pragma unroll
              for (int j = 0; j < 8; ++j) s[j] = 0.f;
              for (int d = 0; d < FDH; d += 4) { const f32x4 qv = *(const LAS f32x4*)(Qs + r * LD + d);
#pragma unroll
                  for (int j = 0; j < 8; ++j) { const f32x4 kv = *(const LAS f32x4*)(Ks + (w * 8 + j) * LD + d); s[j] += (qv.x * kv.x + qv.y * kv.y) + (qv.z * kv.z + qv.w * kv.w); } }
#pragma unroll
              for (int j = 0; j < 8; ++j) { const int pk = k0 + w * 8 + j; float sv = s[j] * scale + cq - cks[w * 8 + j];
                  if (pk > pq || pk < PADR) sv = -__builtin_inff();
                  Ss[r * 65 + w * 8 + j] = sv; } }
            __syncthreads();
            { float tm = -__builtin_inff();
              for (int j = 0; j < 64; ++j) tm = fmaxf(tm, Ss[r * 65 + j]);
              const float mn = fmaxf(m_run, tm), alpha = __expf(m_run - mn); m_run = mn; l_run *= alpha;
#pragma unroll
              for (int i = 0; i < 16; ++i) o[i] *= alpha;
              for (int j = 0; j < 64; ++j) { const float pj = __expf(Ss[r * 65 + j] - mn); l_run += pj;
                  const LAS f32x4* vp = (const LAS f32x4*)(Vs + j * LD + w * 16);
#pragma unroll
                  for (int i = 0; i < 4; ++i) { const f32x4 vv = vp[i]; o[4 * i] += pj * vv.x; o[4 * i + 1] += pj * vv.y; o[4 * i + 2] += pj * vv.z; o[4 * i + 3] += pj * vv.w; } } }
        }
        const float inv = l_run > 0.f ? 1.0f / l_run : 0.f;
        v4u w0, w1;
        w0.x = pk2(o[0] * inv, o[1] * inv); w0.y = pk2(o[2] * inv, o[3] * inv); w0.z = pk2(o[4] * inv, o[5] * inv); w0.w = pk2(o[6] * inv, o[7] * inv);
        w1.x = pk2(o[8] * inv, o[9] * inv); w1.y = pk2(o[10] * inv, o[11] * inv); w1.z = pk2(o[12] * inv, o[13] * inv); w1.w = pk2(o[14] * inv, o[15] * inv);
        bf16* op = O + (rbase + q0 + r) * DM + hd * FDH + w * 16;
        *(v4u*)op = w0; *(v4u*)(op + 8) = w1;
    }
}
__device__ __forceinline__ void phase_attn_mfma(const Params& P, char* lds, int wave) {
    constexpr int TOTAL = NB * FH * 8;
    const fa::bf16* Q = (const fa::bf16*)(P.ws + WS_R1); const fa::bf16* K = (const fa::bf16*)(P.ws + WS_R1 + ACT_BYTES); const fa::bf16* V = (const fa::bf16*)(P.ws + WS_R1 + 2 * ACT_BYTES);
    fa::bf16* O = (fa::bf16*)(P.ws + WS_R2); const float* CCS = (const float*)(P.ws + WS_CCS);
    _Pragma("nounroll") for (int L = blockIdx.x; L < TOTAL; L += gridDim.x) {
        const int bh = ((L & 7) * 8) + (L >> 6), x = (L >> 3) & 7;
        const int b = bh / FH, hd = bh % FH; const size_t r0 = (size_t)b * LP;
        _Pragma("nounroll") for (int pass = 0; pass < 2; ++pass) {
            const int qb = pass ? 15 - x : x;
            fa::PlainBlock B; B.P0 = PADR + NMETA + 256 * qb;
            B.Q = Q + (r0 + B.P0) * DM + hd * FDH; B.O = O + (r0 + B.P0) * DM + hd * FDH; B.K = K + r0 * DM + hd * FDH; B.V = V + r0 * DM + hd * FDH;
            B.C = CCS + (size_t)bh * LP;
            fa::attn_dma_block(B, lds, wave);
        }
    }
}
__device__ __forceinline__ void phase_final(const Params& P, LAS unsigned char* lds, int gw, int NGW, int lane) {
    asm volatile("" : "+v"(lane)); asm volatile("" : "+s"(gw));
    const bf16* H = (const bf16*)(P.ws + WS_H); const bf16* Y = (const bf16*)(P.ws + WS_R2); const int* tok_e = (const int*)(P.ws + WS_TOKE); const int* tok_p = (const int*)(P.ws + WS_TOKP); const MoeTab T = moe_tab(lds);
    _Pragma("nounroll") for (int row = gw; row < MROWS; row += NGW) {
        const int b = row / LP, p = row - b * LP; if (p < PADR + NMETA) continue;
        f32x4 v[8]; load_row_bf(H + (size_t)row * DM, lane, v);
        { const int s0 = T.off[tok_e[row * 2]] + tok_p[row * 2], s1 = T.off[tok_e[row * 2 + 1]] + tok_p[row * 2 + 1];
          add_row_bf16(Y + (size_t)s0 * DM, lane, v); add_row_bf16(Y + (size_t)s1 * DM, lane, v); }
        const float rstd = rms_gain(v, P.norm_final, lane);
        float* orow = P.out + ((size_t)b * SEQ + (p - PADR - NMETA)) * DM;
#pragma unroll
        for (int j = 0; j < 8; ++j) __builtin_nontemporal_store(v[j] * rstd, (f32x4*)(orow + 4 * lane + 256 * j));
    }
}

constexpr int RING_BYTES = 131072, MISC_OFF = RING_BYTES + 64, LDS_BYTES = 155648;
constexpr int NPHASE = 19;
__global__ void __launch_bounds__(NTHREADS, 2) mk_fwd(Params P) {
    extern __shared__ __attribute__((aligned(16))) unsigned char lds_raw[];
    LAS unsigned char* lds = (LAS unsigned char*)lds_raw;
    volatile LAS unsigned* MISC = (volatile LAS unsigned*)(lds + MISC_OFF);
    const int wave = __builtin_amdgcn_readfirstlane((int)threadIdx.x >> 6);
    const int G = gridDim.x, gw = blockIdx.x * NWAVES + wave, NGW = G * NWAVES;
    { const int t0 = wave * 64 + mk_lane_id(); if (t0 < 16) MISC[t0] = 0u; }
    __syncthreads();
    unsigned* ctl = (unsigned*)(P.ws + WS_CTL);
    XcdBarrier bar; bar.bar = ctl + CW_BAR; bar.x = 0; bar.st = MISC + 8; bar.wave = wave;
    const bool one = (P.ph_hi - P.ph_lo) > 1;
    if (one) bar = xcd_barrier_post(ctl + CW_BAR, MISC + 8, wave);
    const int lo = P.ph_lo, hi = P.ph_hi;
#define IN(k) (lo <= (k) && (k) < hi)
#define SEAM(k) do { if (IN(k) && IN((k) + 1)) xcd_barrier(bar); } while (0)
#ifndef PROBE_ATT_REPS
#define PROBE_ATT_REPS 1
#endif
#ifndef PROBE_RET_DRY
#define PROBE_RET_DRY 0
#endif
#ifndef PROBE_DRY_OUT
#define PROBE_DRY_OUT 0
#endif
#ifndef PROBE_DUP
#define PROBE_DUP 0u
#endif
#define DUP(k, ...) do { if ((PROBE_DUP >> (k)) & 1u) { xcd_barrier(bar); __VA_ARGS__; } } while (0)
    bf16* HN = (bf16*)(P.ws + WS_HN); bf16* H = (bf16*)(P.ws + WS_H);
    bf16* R1 = (bf16*)(P.ws + WS_R1); bf16* R2 = (bf16*)(P.ws + WS_R2);

    if (IN(0)) { phase_prologue(P, lds, gw, NGW, wave, mk_lane_id());  DUP(0, { phase_prologue(P, lds, gw, NGW, wave, mk_lane_id()); }); } SEAM(0);
    if (IN(1)) { pg8::Gemm g{HN, (const bf16*)(P.ws + WS_WRI), MROWS, RNIN, DM, 0}; pg8::StaticOrder S; S.init(MROWS, RNIN, G, (int)blockIdx.x);
        EpiRetIn E{R1, R1 + (size_t)MROWS * DM, R2, R2 + (size_t)MROWS * RVW, (const f32x2*)(P.ws + WS_ROPE)};
        pg8::gemm_phase<EpiRetIn, pg8::StaticOrder, true, true>(lds, g, S, E, wave);
        { constexpr int EX = ((MROWS / 256) * (RNIN / 256)) % 256; if (G == 256 && (int)blockIdx.x >= EX) { __syncthreads(); LAS float* scr = (LAS float*)(lds + wave * 16384); const int lane_ = mk_lane_id();
            _Pragma("nounroll") for (int it = ((int)blockIdx.x - EX) * 8 + wave; it < HOLE_MOE0; it += (256 - EX) * 8) tr_moe(P, 0, it, scr, lane_); }
          else if (G != 256) { __syncthreads(); LAS float* scr = (LAS float*)(lds + wave * 16384); const int lane_ = mk_lane_id(); _Pragma("nounroll") for (int it = gw; it < HOLE_MOE0; it += NGW) tr_moe(P, 0, it, scr, lane_); } }
        DUP(1, { pg8::Gemm g{HN, (const bf16*)(P.ws + WS_WRI), MROWS, RNIN, DM, 0}; pg8::StaticOrder S; S.init(MROWS, RNIN, G, (int)blockIdx.x);
        EpiRetIn E{R1, R1 + (size_t)MROWS * DM, R2, R2 + (size_t)MROWS * RVW, (const f32x2*)(P.ws + WS_ROPE)};
        pg8::gemm_phase<EpiRetIn, pg8::StaticOrder, true, true>(lds, g, S, E, wave); }); } SEAM(1);
    if (IN(2)) { if (PROBE_RET_DRY) { rt::phase_retention((const bf16*)R1, (const bf16*)(R1 + (size_t)MROWS * DM), R2, lds, NB, LP, wave, true); __syncthreads(); } rt::phase_retention((const bf16*)R1, (const bf16*)(R1 + (size_t)MROWS * DM), R2, lds, NB, LP, wave); } SEAM(2);
    if (IN(3)) { if ((PROBE_DUP >> 3) & 1u) { phase_gn_gate(P, gw, NGW, mk_lane_id(), true); xcd_barrier(bar); } phase_gn_gate(P, gw, NGW, mk_lane_id()); } SEAM(3);
    if (IN(4)) { { pg8::Gemm g{R2 + (size_t)MROWS * RVW, (const bf16*)(P.ws + WS_WRO), 64 * 256, DM, RVW, 0}; pg8::StaticOrder S; S.init(64 * 256, DM, G, (int)blockIdx.x);
          EpiResidT<true> E{H, 0, P.x, P.meta}; pg8::gemm_phase<EpiResidT<true>, pg8::StaticOrder, true, true>(lds, g, S, E, wave); }
        { pg8::Gemm g{R2 + (size_t)MROWS * RVW, (const bf16*)(P.ws + WS_WRO), MROWS, DM, 256, RVW}; SplitKOrder S{64, 2, 8, 16, 256, G, (int)blockIdx.x};
          EpiSlab E{(float*)(P.ws + WS_R1 + 2 * ACT_BYTES), 256}; pg8::gemm_phase<EpiSlab, SplitKOrder, true, true>(lds, g, S, E, wave); } } SEAM(4);
    if (IN(5)) { if ((PROBE_DUP >> 5) & 1u) { phase_norm_route(P, 0, gw, NGW, mk_lane_id(), 2, 0, lds, wave); xcd_barrier(bar); } phase_norm_route(P, 0, gw, NGW, mk_lane_id(), 0, 16, lds, wave); } SEAM(5);
    if (IN(7)) { moe_tab_build(P, 0, lds, wave); pg8::Gemm g{HN, (const bf16*)(P.ws + WS_WGU), MROWS, NEXP * 1024, DM, 0}; GroupSched S; S.init(moe_tab(lds), (const int*)(P.ws + WS_TOKROW), 4, G, (int)blockIdx.x);
        EpiGateUp E{R2 + (size_t)MAXSLOT * DM, (const float*)(P.ws + WS_TOKWT), moe_tab(lds)}; pg8::gemm_phase<EpiGateUp, GroupSched, true, true, true>(lds, g, S, E, wave); } SEAM(7);
    if (IN(8)) { moe_tab_build(P, 0, lds, wave); pg8::Gemm g{R2 + (size_t)MAXSLOT * DM, (const bf16*)(P.ws + WS_WDN), MAXSLOT, NEXP * DM, FFD, 0}; GroupSched S; S.init(moe_tab(lds), nullptr, 8, G, (int)blockIdx.x);
        EpiDown E{R2}; pg8::gemm_phase<EpiDown, GroupSched, true, true>(lds, g, S, E, wave); } SEAM(8);
    if (IN(9)) { if ((PROBE_DUP >> 9) & 1u) { moe_tab_build(P, 0, lds, wave); phase_l1_entry(P, lds, gw, NGW, wave, mk_lane_id(), true); xcd_barrier(bar); } moe_tab_build(P, 0, lds, wave); phase_l1_entry(P, lds, gw, NGW, wave, mk_lane_id()); } SEAM(9);
    if (IN(11)) { { const int sq = G - 1 - (int)blockIdx.x;
          if (wave == 0) phase_cumsum(P, sq < NB * FH ? sq : NB * FH, G >= NB * FH ? NB * FH : G, mk_lane_id(), lds); }
        pg8::Gemm g{HN, (const bf16*)(P.ws + WS_WFI), MROWS, FNQKV, DM, 0}; pg8::StaticOrder S; S.init(MROWS, FNQKV, G, (int)blockIdx.x);
        pg8::EpiBf16<0> E{R1, DM, nullptr, DM, (size_t)MROWS * DM, 1.0f}; pg8::gemm_phase<pg8::EpiBf16<0>, pg8::StaticOrder, true, true>(lds, g, S, E, wave);
        { constexpr int EX = ((MROWS / 256) * (FNQKV / 256)) % 256; if (G == 256 && (int)blockIdx.x >= EX) { __syncthreads(); LAS float* scr = (LAS float*)(lds + wave * 16384); const int lane_ = mk_lane_id();
            _Pragma("nounroll") for (int it = ((int)blockIdx.x - EX) * 8 + wave; it < HOLE_MOE1; it += (256 - EX) * 8) tr_moe(P, 1, it, scr, lane_); }
          else if (G != 256) { __syncthreads(); LAS float* scr = (LAS float*)(lds + wave * 16384); const int lane_ = mk_lane_id(); _Pragma("nounroll") for (int it = gw; it < HOLE_MOE1; it += NGW) tr_moe(P, 1, it, scr, lane_); } }
        DUP(11, { pg8::Gemm g{HN, (const bf16*)(P.ws + WS_WFI), MROWS, FNQKV, DM, 0}; pg8::StaticOrder S; S.init(MROWS, FNQKV, G, (int)blockIdx.x);
        pg8::EpiBf16<0> E{R1, DM, nullptr, DM, (size_t)MROWS * DM, 1.0f}; pg8::gemm_phase<pg8::EpiBf16<0>, pg8::StaticOrder, true, true>(lds, g, S, E, wave); }); } SEAM(11);
    if (IN(12)) { _Pragma("nounroll") for (int rep_ = 0; rep_ < PROBE_ATT_REPS; ++rep_) { phase_attn_mfma(P, (char*)lds_raw, wave); __syncthreads(); } phase_attn_simple(P, lds, wave); if ((PROBE_DUP >> 20) & 1u) { __syncthreads(); phase_attn_simple(P, lds, wave); } } SEAM(12);
    if (IN(13)) { { pg8::Gemm g{R2, (const bf16*)(P.ws + WS_WFO), 64 * 256, DM, DM, 0}; pg8::StaticOrder S; S.init(64 * 256, DM, G, (int)blockIdx.x);
          EpiResidT<false> E{H, 0, nullptr, nullptr}; pg8::gemm_phase<EpiResidT<false>, pg8::StaticOrder, true, true>(lds, g, S, E, wave); }
        { pg8::Gemm g{R2, (const bf16*)(P.ws + WS_WFO), MROWS, DM, 256, DM}; SplitKOrder S{64, 2, 8, 8, 256, G, (int)blockIdx.x};
          EpiSlab E{(float*)(P.ws + WS_R1 + 2 * ACT_BYTES), 256}; pg8::gemm_phase<EpiSlab, SplitKOrder, true, true>(lds, g, S, E, wave); } } SEAM(13);
    if (IN(14)) { if ((PROBE_DUP >> 14) & 1u) { phase_norm_route(P, 1, gw, NGW, mk_lane_id(), 3, 0, lds, wave); xcd_barrier(bar); } phase_norm_route(P, 1, gw, NGW, mk_lane_id(), 1, 8, lds, wave); } SEAM(14);
    if (IN(16)) { moe_tab_build(P, 1, lds, wave); pg8::Gemm g{HN, (const bf16*)(P.ws + WS_WGU), MROWS, NEXP * 1024, DM, 0}; GroupSched S; S.init(moe_tab(lds), (const int*)(P.ws + WS_TOKROW), 4, G, (int)blockIdx.x);
        EpiGateUp E{R2 + (size_t)MAXSLOT * DM, (const float*)(P.ws + WS_TOKWT), moe_tab(lds)}; pg8::gemm_phase<EpiGateUp, GroupSched, true, true, true>(lds, g, S, E, wave); } SEAM(16);
    if (IN(17)) { moe_tab_build(P, 1, lds, wave); pg8::Gemm g{R2 + (size_t)MAXSLOT * DM, (const bf16*)(P.ws + WS_WDN), MAXSLOT, NEXP * DM, FFD, 0}; GroupSched S; S.init(moe_tab(lds), nullptr, 8, G, (int)blockIdx.x);
        EpiDown E{R2}; pg8::gemm_phase<EpiDown, GroupSched, true, true>(lds, g, S, E, wave); } SEAM(17);
    if (IN(18)) { moe_tab_build(P, 1, lds, wave); phase_final(P, lds, gw, NGW, mk_lane_id()); }
#undef IN
#undef SEAM
}

extern "C" void kernel_launch(void* const* d_in, const int* in_sizes, int n_in, void* d_out, int out_size, void* d_ws, size_t ws_size, hipStream_t stream) {
    static int grid = 0;
    if (grid == 0) {
        if (n_in != 18 || ws_size < WS_END) { fprintf(stderr, "kernel_launch: expected 18 inputs and >= %zu bytes of workspace; got %d, %zu\n", (size_t)WS_END, n_in, ws_size); grid = -1; return; }
        int dev = 0, cus = 0, per_cu = 0;
        if (hipGetDevice(&dev) != hipSuccess || hipDeviceGetAttribute(&cus, hipDeviceAttributeMultiprocessorCount, dev) != hipSuccess) { grid = -1; return; }
        if (hipFuncSetAttribute((const void*)mk_fwd, hipFuncAttributeMaxDynamicSharedMemorySize, LDS_BYTES) != hipSuccess) { fprintf(stderr, "kernel_launch: hipFuncSetAttribute failed\n"); grid = -1; return; }
        if (hipOccupancyMaxActiveBlocksPerMultiprocessor(&per_cu, (const void*)mk_fwd, NTHREADS, LDS_BYTES) != hipSuccess || per_cu < 1)
            fprintf(stderr, "kernel_launch: note: occupancy query reports %d workgroups per CU\n", per_cu);
        (void)hipGetLastError();
        grid = cus;
    }
    if (grid < 0) return;
    (void)hipMemsetAsync((char*)d_ws + WS_CTL, 0, CTL_ZERO_BYTES, stream);
    Params p{};
    p.x = (const float*)d_in[0]; p.meta = (const float*)d_in[1]; p.norm_mixer = (const float*)d_in[2]; p.norm_ffn = (const float*)d_in[3]; p.norm_final = (const float*)d_in[4];
    p.ret_w_in = (const float*)d_in[5]; p.ret_gn = (const float*)d_in[6]; p.ret_w_out = (const float*)d_in[7];
    p.fox_w_in = (const float*)d_in[8]; p.fox_b_f = (const float*)d_in[9]; p.fox_w_out = (const float*)d_in[10];
    p.moe_w_rg = (const float*)d_in[11]; p.moe_b_rg = (const float*)d_in[12]; p.moe_w_re = (const float*)d_in[13]; p.moe_b_re = (const float*)d_in[14];
    p.moe_w_gate = (const float*)d_in[15]; p.moe_w_up = (const float*)d_in[16]; p.moe_w_down = (const float*)d_in[17];
    p.out = (float*)d_out; p.ws = (unsigned char*)d_ws;
#if MK_ONE_LAUNCH
    p.ph_lo = 0; p.ph_hi = NPHASE;
    hipLaunchKernelGGL(mk_fwd, dim3(grid), dim3(NTHREADS), LDS_BYTES, stream, p);
#else
    for (int k = 0; k < NPHASE; ++k) { p.ph_lo = k; p.ph_hi = k + 1; hipLaunchKernelGGL(mk_fwd, dim3(grid), dim3(NTHREADS), LDS_BYTES, stream, p); }
#endif
}
```
